# Optimizing an MI355X kernel written in HIP

```python
import jax, jax.numpy as jnp
from jax import lax
import numpy as np

D_MODEL = 2048
BATCH = 4
SEQ = 4096
DEPTH = 2

N_EVEN = (DEPTH + 1) // 2
N_ODD = DEPTH // 2
PAR_WIDTH = D_MODEL
SB_WIDTH = PAR_WIDTH // 2
SB_HEADS = 8
SB_HEAD_DIM = SB_WIDTH // SB_HEADS
SB_BLOCK = 128
HG_WIDTH = PAR_WIDTH - SB_WIDTH
HG_HEADS = 8
HG_VDIM = HG_WIDTH // HG_HEADS
HG_KDIM = 128
HG_KEY_WIDTH = HG_HEADS * HG_KDIM
HG_CHUNK = 64
PAR_IN = 3 * SB_WIDTH + 2 * HG_KEY_WIDTH + 2 * HG_WIDTH
PAR_SPLITS = [SB_WIDTH, 2 * SB_WIDTH, 3 * SB_WIDTH, 3 * SB_WIDTH + HG_KEY_WIDTH,
              3 * SB_WIDTH + 2 * HG_KEY_WIDTH, 3 * SB_WIDTH + 2 * HG_KEY_WIDTH + HG_WIDTH]
SG_WIDTH = D_MODEL
SG_GROUPS = 8
SG_CHUNK = 128
FFN_DIM = 11 * D_MODEL // 4
CONV_WIDTH = 3
NORM_EPS = 1e-6

kernel_name = "hybrid_stickbreak_hgrn2_gmlp_convffn_adaln"


def rms_norm(x, gain):
    x32 = x.astype(jnp.float32)
    y = x32 * lax.rsqrt(jnp.mean(x32 * x32, axis=-1, keepdims=True) + NORM_EPS)
    return (y * gain.astype(jnp.float32)).astype(x.dtype)


def layer_norm(x, gain, bias):
    x32 = x.astype(jnp.float32)
    mu = jnp.mean(x32, axis=-1, keepdims=True)
    xc = x32 - mu
    y = xc * lax.rsqrt(jnp.mean(xc * xc, axis=-1, keepdims=True) + NORM_EPS)
    return (y * gain.astype(jnp.float32) + bias.astype(jnp.float32)).astype(x.dtype)


def stick_breaking_attention(q, k, v):
    S = q.shape[2]
    scale = q.shape[-1] ** -0.5
    outs = []
    for blk in range(S // SB_BLOCK):
        q0, q1 = blk * SB_BLOCK, (blk + 1) * SB_BLOCK
        z = jnp.einsum('bhtd,bhsd->bhts', q[:, :, q0:q1], k[:, :, :q1]).astype(jnp.float32) * scale
        t_idx = q0 + jnp.arange(SB_BLOCK)[:, None]
        s_idx = jnp.arange(q1)[None, :]
        strict = s_idx < t_idx
        log_keep = jnp.where(strict, jax.nn.log_sigmoid(-z), 0.0)
        tail = lax.cumsum(log_keep, axis=3, reverse=True) - log_keep
        w = jnp.where(strict, jnp.exp(jax.nn.log_sigmoid(z) + tail), 0.0)
        outs.append(jnp.einsum('bhts,bhsd->bhtd', w.astype(v.dtype), v[:, :, :q1]))
    return jnp.concatenate(outs, axis=2)


def hgrn2_recurrence(q, f_logit, i, g, lower_bound, out_gain):
    dtype = q.dtype
    Bn, S, H, dk = q.shape
    dv = i.shape[-1]
    n = S // HG_CHUNK
    lb = lower_bound.astype(jnp.float32)
    f = lb + (1.0 - lb) * jax.nn.sigmoid(f_logit.astype(jnp.float32))
    log_f = jnp.log(f)
    k = 1.0 - f
    qf = jax.nn.silu(q.astype(jnp.float32))

    def to_chunks(t):
        return t.transpose(0, 2, 1, 3).reshape(Bn, H, n, HG_CHUNK, t.shape[-1])

    qc, kc, vc, lc = (to_chunks(t) for t in (qf, k, i.astype(jnp.float32), log_f))
    G = jnp.cumsum(lc, axis=3)
    G_last = G[:, :, :, -1:, :]
    q_dec = qc * jnp.exp(G)
    k_inv = kc * jnp.exp(-G)
    k_end = kc * jnp.exp(G_last - G)
    causal = jnp.tril(jnp.ones((HG_CHUNK, HG_CHUNK), dtype=bool))
    scores = jnp.where(causal, jnp.einsum('bhntd,bhnsd->bhnts', q_dec, k_inv), 0.0)
    o_intra = jnp.einsum('bhnts,bhnsv->bhntv', scores, vc)

    def step(state, xs):
        q_d, k_e, v_c, decay = xs
        o = jnp.einsum('bhtd,bhdv->bhtv', q_d, state)
        state = decay[..., None] * state + jnp.einsum('bhtd,bhtv->bhdv', k_e, v_c)
        return state, o

    xs = tuple(jnp.moveaxis(t, 2, 0) for t in (q_dec, k_end, vc, jnp.exp(G_last[:, :, :, 0, :])))
    state0 = jnp.zeros((Bn, H, dk, dv), jnp.float32)
    _, o_inter = lax.scan(step, state0, xs)
    o = o_intra + jnp.moveaxis(o_inter, 0, 2)
    o = o.reshape(Bn, H, S, dv).transpose(0, 2, 1, 3)
    o = o * lax.rsqrt(jnp.mean(o * o, axis=-1, keepdims=True) + NORM_EPS) * out_gain.astype(jnp.float32)
    return (o * jax.nn.silu(g.astype(jnp.float32))).astype(dtype)


def parallel_mixer(h, w_in, w_out, lower_bound, hg_gain):
    Bn, S, _ = h.shape
    proj = h @ w_in
    sb_q, sb_k, sb_v, hg_q, hg_f, hg_i, hg_g = jnp.split(proj, PAR_SPLITS, axis=-1)
    bhsd = lambda t: t.reshape(Bn, S, SB_HEADS, SB_HEAD_DIM).transpose(0, 2, 1, 3)
    o_sb = stick_breaking_attention(bhsd(sb_q), bhsd(sb_k), bhsd(sb_v))
    o_sb = o_sb.transpose(0, 2, 1, 3).reshape(Bn, S, SB_WIDTH)
    bshd = lambda t: t.reshape(Bn, S, HG_HEADS, -1)
    o_hg = hgrn2_recurrence(bshd(hg_q), bshd(hg_f), bshd(hg_i), bshd(hg_g),
                            lower_bound.reshape(HG_HEADS, HG_KDIM), hg_gain)
    o_hg = o_hg.reshape(Bn, S, HG_WIDTH)
    return jnp.concatenate([o_sb, o_hg], axis=-1) @ w_out


def chunked_spatial_gating_mlp(h, w_in, v_gain, v_bias, w_pos, b_pos, w_out):
    Bn, S, _ = h.shape
    z = jax.nn.gelu(h @ w_in, approximate=False)
    u, v = jnp.split(z, 2, axis=-1)
    v = layer_norm(v, v_gain, v_bias)
    n = S // SG_CHUNK
    vg = v.reshape(Bn, n, SG_CHUNK, SG_GROUPS, SG_WIDTH // SG_GROUPS)
    causal = jnp.tril(jnp.ones((SG_CHUNK, SG_CHUNK), dtype=bool))
    w = jnp.where(causal, w_pos, 0.0).astype(v.dtype)
    mixed = jnp.einsum('gts,bnsgc->bntgc', w, vg) + b_pos.T[None, None, :, :, None]
    return (u * mixed.reshape(Bn, S, SG_WIDTH)) @ w_out


def conv_ffn(h, w_up, conv_w, conv_b, w_down):
    S = h.shape[1]
    a = h @ w_up
    ap = jnp.pad(a, ((0, 0), (CONV_WIDTH - 1, 0), (0, 0)))
    a = conv_b + sum(conv_w[j] * ap[:, j:j + S] for j in range(CONV_WIDTH))
    gate, val = jnp.split(a, 2, axis=-1)
    return (jax.nn.silu(gate) * val) @ w_down


def setup_inputs(seed: int = 0) -> dict:
    key = jax.random.key(seed)
    ks = jax.random.split(key, 24)
    f32 = jnp.float32
    nrm = lambda k, shape, scale: jax.random.normal(k, shape, f32) * scale
    gain = lambda k, shape: 1.0 + 0.05 * jax.random.normal(k, shape, f32)
    D = D_MODEL
    return {
        "x": nrm(ks[0], (BATCH, SEQ, D), 1.0),
        "c": nrm(ks[1], (BATCH, D), 1.0),
        "ada_w": nrm(ks[2], (DEPTH, D, 6 * D), D ** -0.5),
        "ada_b": nrm(ks[3], (DEPTH, 6 * D), 0.01),
        "mix_norm": gain(ks[4], (DEPTH, D)),
        "ffn_norm": gain(ks[5], (DEPTH, D)),
        "par_w_in": nrm(ks[6], (N_EVEN, D, PAR_IN), D ** -0.5),
        "par_w_out": nrm(ks[7], (N_EVEN, PAR_WIDTH, D), PAR_WIDTH ** -0.5),
        "hg_lb_logits": nrm(ks[8], (N_EVEN + 1, HG_KEY_WIDTH), 0.1),
        "hg_out_norm": gain(ks[9], (N_EVEN, HG_HEADS, HG_VDIM)),
        "sg_w_in": nrm(ks[10], (N_ODD, D, 2 * SG_WIDTH), D ** -0.5),
        "sg_v_gain": gain(ks[11], (N_ODD, SG_WIDTH)),
        "sg_v_bias": nrm(ks[12], (N_ODD, SG_WIDTH), 0.02),
        "sg_w_pos": nrm(ks[13], (N_ODD, SG_GROUPS, SG_CHUNK, SG_CHUNK), SG_CHUNK ** -0.5),
        "sg_b_pos": nrm(ks[14], (N_ODD, SG_GROUPS, SG_CHUNK), 0.02),
        "sg_w_out": nrm(ks[15], (N_ODD, SG_WIDTH, D), SG_WIDTH ** -0.5),
        "ffn_up": nrm(ks[16], (DEPTH, D, 2 * FFN_DIM), D ** -0.5),
        "ffn_conv_w": nrm(ks[17], (DEPTH, CONV_WIDTH, 2 * FFN_DIM), CONV_WIDTH ** -0.5),
        "ffn_conv_b": nrm(ks[18], (DEPTH, 2 * FFN_DIM), 0.02),
        "ffn_down": nrm(ks[19], (DEPTH, FFN_DIM, D), FFN_DIM ** -0.5),
        "final_norm": gain(ks[20], (D,)),
    }


def reference(x, c, ada_w, ada_b, mix_norm, ffn_norm, par_w_in, par_w_out, hg_lb_logits,
              hg_out_norm, sg_w_in, sg_v_gain, sg_v_bias, sg_w_pos, sg_b_pos, sg_w_out,
              ffn_up, ffn_conv_w, ffn_conv_b, ffn_down, final_norm):
    cond = jax.nn.silu(c)
    lower_bounds = jnp.cumsum(jax.nn.softmax(hg_lb_logits.astype(jnp.float32), axis=0), axis=0)
    for layer in range(DEPTH):
        j = layer // 2
        mod = cond @ ada_w[layer] + ada_b[layer]
        sh1, sc1, g1, sh2, sc2, g2 = jnp.split(mod[:, None, :], 6, axis=-1)
        h = rms_norm(x, mix_norm[layer]) * (1.0 + sc1) + sh1
        if layer % 2 == 0:
            y = parallel_mixer(h, par_w_in[j], par_w_out[j], lower_bounds[j], hg_out_norm[j])
        else:
            y = chunked_spatial_gating_mlp(h, sg_w_in[j], sg_v_gain[j], sg_v_bias[j],
                                           sg_w_pos[j], sg_b_pos[j], sg_w_out[j])
        x = x + g1 * y
        h = rms_norm(x, ffn_norm[layer]) * (1.0 + sc2) + sh2
        x = x + g2 * conv_ffn(h, ffn_up[layer], ffn_conv_w[layer], ffn_conv_b[layer], ffn_down[layer])
    return rms_norm(x, final_norm)
```

```cpp
#include <hip/hip_runtime.h>
#include <hip/hip_cooperative_groups.h>
#include <cstdio>
#include <cstdint>
namespace cg = cooperative_groups;
__device__ __forceinline__ int opaque_tid() { int t = threadIdx.x; asm volatile("" : "+v"(t)); return t; }
namespace pg8 {
#define PG8_LAS __attribute__((address_space(3)))
typedef unsigned short bf16_t;
typedef short bf16x8 __attribute__((ext_vector_type(8)));
typedef float f32x4 __attribute__((ext_vector_type(4)));
typedef unsigned u32x4 __attribute__((ext_vector_type(4)));
constexpr int BM = 256, BK = 64, HALF = 128, HTB = HALF * BK * 2  , STAGE_BYTES = 8 * HTB, NXCD = 8, WGM = 8;

__host__ __device__ __forceinline__ int lds_byte(int r, int c) { const int st = (r >> 4) * 2 + (c >> 5), rr = r & 15, cc = c & 31, ob = rr * 64 + cc * 2; return st * 1024 + (ob ^ (((ob >> 9) & 1) << 5)); }
__host__ __device__ __forceinline__ void stage_rc(int b, int& R, int& C) { const int st = b / 1024, sb = b % 1024, swz = sb ^ (((sb >> 9) & 1) << 5); R = (st >> 1) * 16 + swz / 64; C = (st & 1) * 32 + (swz % 64) / 2; }
__host__ __device__ __forceinline__ int perm32(int rho) { const int n = rho >> 4, i = rho & 15; return 8 * (i >> 2) + 4 * n + (i & 3); }

struct Unit { int pm, pn; };
struct Gemm { const bf16_t* A; const bf16_t* Bt; int M, N, K; };

struct StaticOrder {
    int nM, nN, nwg, G, c;
    __host__ __device__ void init(int M, int N, int G_, int c_) { nM = M / BM; nN = N / BM; nwg = nM * nN; G = G_; c = c_; }
    __host__ __device__ bool next(int i, Unit& u) const {
        const long L = (long)i * G + c; if (L >= nwg) return false;
        int wgid = (int)L; { const int q = nwg / NXCD, r = nwg % NXCD, xcd = wgid % NXCD, off = wgid / NXCD; wgid = (xcd < r ? xcd * (q + 1) : r * (q + 1) + (xcd - r) * q) + off; }
        const int nig = WGM * nN, gid = wgid / nig, fm = gid * WGM, gsz = (nM - fm) < WGM ? (nM - fm) : WGM;
        u.pm = fm + ((wgid % nig) % gsz); u.pn = (wgid % nig) / gsz; return true;
    }
    __device__ __forceinline__ void a_ready(const Unit&) const {}
    __device__ __forceinline__ void done(const Unit&) const {}
};
struct PanelOrder {
    int c, nr;
    __host__ __device__ void init(int M, int, int, int c_) { c = c_; nr = M / (32 * BM); }
    __host__ __device__ bool next(int i, Unit& u) const { if (i >= nr) return false; const int xcd = c & 7, idx = c >> 3; u.pm = 32 * i + 4 * xcd + (idx >> 3); u.pn = idx & 7; return true; }
    __device__ __forceinline__ void a_ready(const Unit&) const {}
    __device__ __forceinline__ void done(const Unit&) const {}
};

typedef float f32x2 __attribute__((ext_vector_type(2)));
typedef __bf16 bf16v2 __attribute__((ext_vector_type(2)));
__device__ __forceinline__ unsigned cvt_pk_bf16(float lo, float hi) { f32x2 v = {lo, hi}; return __builtin_bit_cast(unsigned, __builtin_convertvector(v, bf16v2)); }
__device__ __forceinline__ f32x2 gelu_pk(f32x2 v) {
    const f32x2 av = __builtin_elementwise_abs(v), d = av * 0.2316418882f + 1.0f;
    f32x2 t; t.x = __builtin_amdgcn_rcpf(d.x); t.y = __builtin_amdgcn_rcpf(d.y);
    f32x2 q = t * 0.5307027145f + (-0.7265760135f); q = q * t + 0.7107068705f; q = q * t + (-0.142248368f); q = q * t + 0.127414796f; q = q * t;
    const f32x2 s = (v * v) * (-0.72134752044f);
    f32x2 e; e.x = __builtin_amdgcn_exp2f(s.x); e.y = __builtin_amdgcn_exp2f(s.y);
    const f32x2 m = v * (q * e), r = v - m;
    f32x2 o; o.x = v.x < 0.f ? m.x : r.x; o.y = v.y < 0.f ? m.y : r.y; return o;
}
struct EpiBf16 {
    static constexpr bool PERM = true, AFTER_DRAIN = false;
    bf16_t* O; int ldc; int act;
    __device__ __forceinline__ void operator()(const f32x4 (&acc)[2][2][4][2], const Unit& u, int wr, int wc, int fr, int fq) const {
        const int row0 = u.pm * BM + wr * 64 + fr; const int col0 = u.pn * BM + wc * 32 + 8 * fq;
#pragma unroll
        for (int ai = 0; ai < 2; ++ai)
#pragma unroll
            for (int m = 0; m < 4; ++m) { bf16_t* rowp = O + (size_t)(row0 + ai * HALF + m * 16) * ldc + col0;
#pragma unroll
                for (int bj = 0; bj < 2; ++bj) { f32x4 v0 = acc[ai][bj][m][0], v1 = acc[ai][bj][m][1];
                    if (act) { f32x2 a = gelu_pk((f32x2){v0[0], v0[1]}), b = gelu_pk((f32x2){v0[2], v0[3]}), c = gelu_pk((f32x2){v1[0], v1[1]}), d = gelu_pk((f32x2){v1[2], v1[3]});
                        v0 = (f32x4){a.x, a.y, b.x, b.y}; v1 = (f32x4){c.x, c.y, d.x, d.y}; }
                    u32x4 w; w.x = cvt_pk_bf16(v0[0], v0[1]); w.y = cvt_pk_bf16(v0[2], v0[3]); w.z = cvt_pk_bf16(v1[0], v1[1]); w.w = cvt_pk_bf16(v1[2], v1[3]);
                    *(u32x4*)(rowp + bj * HALF) = w; } }
    }
};
struct EpiResid {
    static constexpr bool PERM = false, AFTER_DRAIN = false;
    const float* Xin; float* Xout; const float* gate;
    __device__ __forceinline__ void operator()(const f32x4 (&acc)[2][2][4][2], const Unit& u, int wr, int wc, int fr, int fq) const {
        const int row0 = u.pm * BM + wr * 64 + fr, col0 = u.pn * BM + wc * 32 + 4 * fq; const int b = u.pm >> 4;
        f32x4 gv[2][2];
#pragma unroll
        for (int bj = 0; bj < 2; ++bj)
#pragma unroll
            for (int n = 0; n < 2; ++n) gv[bj][n] = *(const f32x4*)(gate + (size_t)b * 12288 + col0 + bj * HALF + n * 16);
        f32x4 xa[2][2], xb[2][2];
#define RES_LD(dst, g) { const size_t off_ = (size_t)(row0 + ((g) >> 2) * HALF + ((g) & 3) * 16) * 2048 + col0; \
            dst[0][0] = *(const f32x4*)(Xin + off_); dst[0][1] = *(const f32x4*)(Xin + off_ + 16); dst[1][0] = *(const f32x4*)(Xin + off_ + HALF); dst[1][1] = *(const f32x4*)(Xin + off_ + HALF + 16); }
#define RES_ST(src, g) { const size_t off_ = (size_t)(row0 + ((g) >> 2) * HALF + ((g) & 3) * 16) * 2048 + col0; \
            *(f32x4*)(Xout + off_) = src[0][0] + gv[0][0] * acc[(g) >> 2][0][(g) & 3][0]; *(f32x4*)(Xout + off_ + 16) = src[0][1] + gv[0][1] * acc[(g) >> 2][0][(g) & 3][1]; \
            *(f32x4*)(Xout + off_ + HALF) = src[1][0] + gv[1][0] * acc[(g) >> 2][1][(g) & 3][0]; *(f32x4*)(Xout + off_ + HALF + 16) = src[1][1] + gv[1][1] * acc[(g) >> 2][1][(g) & 3][1]; }
        RES_LD(xa, 0)
#pragma unroll
        for (int g = 0; g < 8; g += 2) {
            RES_LD(xb, g + 1)
            asm volatile("" ::: "memory");
            RES_ST(xa, g)
            asm volatile("" ::: "memory");
            if (g + 2 < 8) RES_LD(xa, g + 2)
            asm volatile("" ::: "memory");
            RES_ST(xb, g + 1)
            asm volatile("" ::: "memory");
        }
#undef RES_LD
#undef RES_ST
    }
};

typedef unsigned u32x2 __attribute__((ext_vector_type(2)));
template <int XIN, int XST> struct EpiResidNorm {
    static constexpr bool PERM = false, AFTER_DRAIN = false;
    const void* Xin; void* Xout; const float* gate; const float* gain; const float* sc; const float* sh; bf16_t* H; float* rowss; unsigned* cnt;
    __device__ __forceinline__ void operator()(f32x4 (&acc)[2][2][4][2], const Unit& u, int wr, int wc, int fr, int fq) const {
        const int row0 = u.pm * BM + wr * 64 + fr, col0 = u.pn * BM + wc * 32 + 4 * fq; const int b = u.pm >> 4;
        const bool fin = (sc == nullptr);
        f32x4 gv[2][2];
#pragma unroll
        for (int bj = 0; bj < 2; ++bj)
#pragma unroll
            for (int n = 0; n < 2; ++n) gv[bj][n] = *(const f32x4*)(gate + (size_t)b * 12288 + col0 + bj * HALF + n * 16);
        f32x4 xa[2][2], xb[2][2];
#define RES_LD1(dst, o2) { if (XIN == 0) dst = *(const f32x4*)((const float*)Xin + (o2)); else { const u32x2 w_ = *(const u32x2*)((const bf16_t*)Xin + (o2)); \
                dst = (f32x4){__uint_as_float(w_.x << 16), __uint_as_float(w_.x & 0xffff0000u), __uint_as_float(w_.y << 16), __uint_as_float(w_.y & 0xffff0000u)}; } }
#define RES_LD(dst, g) { const size_t off_ = (size_t)(row0 + ((g) >> 2) * HALF + ((g) & 3) * 16) * 2048 + col0; \
            RES_LD1(dst[0][0], off_) RES_LD1(dst[0][1], off_ + 16) RES_LD1(dst[1][0], off_ + HALF) RES_LD1(dst[1][1], off_ + HALF + 16) }
#define RES_ST(src, g) { const size_t off_ = (size_t)(row0 + ((g) >> 2) * HALF + ((g) & 3) * 16) * 2048 + col0; float ss_ = 0.f; \
            _Pragma("unroll") for (int bj_ = 0; bj_ < 2; ++bj_) _Pragma("unroll") for (int n_ = 0; n_ < 2; ++n_) { \
                const f32x4 x_ = src[bj_][n_] + gv[bj_][n_] * acc[(g) >> 2][bj_][(g) & 3][n_]; acc[(g) >> 2][bj_][(g) & 3][n_] = x_; \
                ss_ += (x_[0] * x_[0] + x_[1] * x_[1]) + (x_[2] * x_[2] + x_[3] * x_[3]); \
                if (XST == 0) *(f32x4*)((float*)Xout + off_ + bj_ * HALF + n_ * 16) = x_; \
                if (XST == 1) { u32x2 w_; w_.x = cvt_pk_bf16(x_[0], x_[1]); w_.y = cvt_pk_bf16(x_[2], x_[3]); *(u32x2*)((bf16_t*)Xout + off_ + bj_ * HALF + n_ * 16) = w_; } } \
            ss_ += __shfl_xor(ss_, 16); ss_ += __shfl_xor(ss_, 32); \
            if (fq == 0) (void)__hip_atomic_fetch_add(rowss + row0 + ((g) >> 2) * HALF + ((g) & 3) * 16, ss_, __ATOMIC_RELAXED, __HIP_MEMORY_SCOPE_AGENT); }
        RES_LD(xa, 0)
#pragma unroll
        for (int g = 0; g < 8; g += 2) {
            RES_LD(xb, g + 1)
            asm volatile("" ::: "memory");
            RES_ST(xa, g)
            asm volatile("" ::: "memory");
            if (g + 2 < 8) RES_LD(xa, g + 2)
            asm volatile("" ::: "memory");
            RES_ST(xb, g + 1)
            asm volatile("" ::: "memory");
        }
#undef RES_LD
#undef RES_LD1
#undef RES_ST
        asm volatile("s_waitcnt vmcnt(0)" ::: "memory");
        unsigned* c = cnt + 64 * u.pm;
        if (fq * 16 + fr == 0) (void)__hip_atomic_fetch_add(c, 1u, __ATOMIC_RELAXED, __HIP_MEMORY_SCOPE_AGENT);
        { unsigned sp = 0;
          while ((unsigned)__builtin_amdgcn_readfirstlane((int)__hip_atomic_load(c, __ATOMIC_RELAXED, __HIP_MEMORY_SCOPE_AGENT)) < 64u) { __builtin_amdgcn_s_sleep(1); if (++sp > (1u << 22)) break; } }
        f32x4 gg[2][2], hh[2][2];
#pragma unroll
        for (int bj = 0; bj < 2; ++bj)
#pragma unroll
            for (int n = 0; n < 2; ++n) { const int cc = col0 + bj * HALF + n * 16; const f32x4 ga = *(const f32x4*)(gain + cc);
                if (fin) { gg[bj][n] = ga; hh[bj][n] = (f32x4){0.f, 0.f, 0.f, 0.f}; }
                else { gg[bj][n] = ga * (*(const f32x4*)(sc + (size_t)b * 12288 + cc) + 1.0f); hh[bj][n] = *(const f32x4*)(sh + (size_t)b * 12288 + cc); } }
        float rsv[8];
        { const float* rp = rowss + row0;
          asm volatile("global_load_dword %0, %8, off sc1\n\tglobal_load_dword %1, %8, off offset:64 sc1\n\tglobal_load_dword %2, %8, off offset:128 sc1\n\tglobal_load_dword %3, %8, off offset:192 sc1\n\t"
                       "global_load_dword %4, %8, off offset:512 sc1\n\tglobal_load_dword %5, %8, off offset:576 sc1\n\tglobal_load_dword %6, %8, off offset:640 sc1\n\tglobal_load_dword %7, %8, off offset:704 sc1\n\t"
                       "s_waitcnt vmcnt(0)"
                       : "=&v"(rsv[0]), "=&v"(rsv[1]), "=&v"(rsv[2]), "=&v"(rsv[3]), "=&v"(rsv[4]), "=&v"(rsv[5]), "=&v"(rsv[6]), "=&v"(rsv[7]) : "v"(rp) : "memory"); }
#pragma unroll
        for (int g = 0; g < 8; ++g) {
            const int row = row0 + (g >> 2) * HALF + (g & 3) * 16;
            const float rstd = __builtin_amdgcn_rsqf(rsv[g] * (1.0f / 2048.0f) + 1e-6f);
#pragma unroll
            for (int bj = 0; bj < 2; ++bj)
#pragma unroll
                for (int n = 0; n < 2; ++n) { const f32x4 o = acc[g >> 2][bj][g & 3][n] * rstd * gg[bj][n] + hh[bj][n]; const size_t off = (size_t)row * 2048 + col0 + bj * HALF + n * 16;
                    if (fin) *(f32x4*)((float*)Xout + off) = o;
                    else { u32x2 w; w.x = cvt_pk_bf16(o[0], o[1]); w.y = cvt_pk_bf16(o[2], o[3]); *(u32x2*)(H + off) = w; } }
        }
    }
};

__device__ __forceinline__ float dpp_ror1(float v) { const int x = __builtin_bit_cast(int, v); return __builtin_bit_cast(float, __builtin_amdgcn_update_dpp(x, x, 0x121, 0xf, 0xf, false)); }
__device__ __forceinline__ float dpp_ror2(float v) { const int x = __builtin_bit_cast(int, v); return __builtin_bit_cast(float, __builtin_amdgcn_update_dpp(x, x, 0x122, 0xf, 0xf, false)); }
__device__ __forceinline__ float dpp_shr1(float old, float v) { return __builtin_bit_cast(float, __builtin_amdgcn_update_dpp(__builtin_bit_cast(int, old), __builtin_bit_cast(int, v), 0x111, 0xf, 0xf, false)); }
__device__ __forceinline__ float dpp_shr2(float old, float v) { return __builtin_bit_cast(float, __builtin_amdgcn_update_dpp(__builtin_bit_cast(int, old), __builtin_bit_cast(int, v), 0x112, 0xf, 0xf, false)); }
struct EpiConv {
    static constexpr bool PERM = false, AFTER_DRAIN = false;
    bf16_t* U; float* SB; const float* cw; const float* cb; PG8_LAS unsigned char* xb;
    __device__ __forceinline__ void operator()(const f32x4 (&acc)[2][2][4][2], const Unit& u, int wr, int wc, int fr, int fq) const {
        constexpr int FFc = 5632, FF2c = 11264;
        const int lane = fq * 16 + fr, l16 = fq * 16;
        const int row0 = u.pm * BM + wr * 64 + fr, jcol = u.pn * HALF + wc * 32 + 4 * fq;
        const f32x4 pwg0 = *(const f32x4*)(cw + jcol), pwg1 = *(const f32x4*)(cw + FF2c + jcol), pwg2 = *(const f32x4*)(cw + 2 * FF2c + jcol), pbg = *(const f32x4*)(cb + jcol);
        const f32x4 pwv0 = *(const f32x4*)(cw + FFc + jcol), pwv1 = *(const f32x4*)(cw + FF2c + FFc + jcol), pwv2 = *(const f32x4*)(cw + 2 * FF2c + FFc + jcol), pbv = *(const f32x4*)(cb + FFc + jcol);
#pragma unroll
        for (int ai = 0; ai < 2; ++ai) {
            if (fr >= 14) {
                PG8_LAS f32x4* dst = (PG8_LAS f32x4*)(xb + (((((ai * 2 + wr) * 4 + wc) * 2 + (fr - 14)) * 4 + fq) * 64));
                dst[0] = acc[ai][0][3][0]; dst[1] = acc[ai][0][3][1]; dst[2] = acc[ai][1][3][0]; dst[3] = acc[ai][1][3][1];
            }
        }
        { const int colb = u.pn * BM + wc * 32 + 4 * fq;
          if (wr == 0 && fr < 2) { float* sb = SB + ((size_t)(u.pm * 4 + fr)) * FF2c + colb;
              *(f32x4*)(sb) = acc[0][0][0][0]; *(f32x4*)(sb + 16) = acc[0][0][0][1]; *(f32x4*)(sb + HALF) = acc[0][1][0][0]; *(f32x4*)(sb + HALF + 16) = acc[0][1][0][1]; }
          if (wr == 1 && fr >= 14) { float* sb = SB + ((size_t)(u.pm * 4 + 2 + (fr - 14))) * FF2c + colb;
              *(f32x4*)(sb) = acc[1][0][3][0]; *(f32x4*)(sb + 16) = acc[1][0][3][1]; *(f32x4*)(sb + HALF) = acc[1][1][3][0]; *(f32x4*)(sb + HALF + 16) = acc[1][1][3][1]; } }
        asm volatile("s_waitcnt lgkmcnt(0)" ::: "memory"); __builtin_amdgcn_s_barrier(); asm volatile("" ::: "memory");
#pragma unroll
        for (int n = 0; n < 2; ++n) {
            const int j = jcol + 16 * n;
            f32x4 wg0, wg1, wg2, bg, wv0, wv1, wv2, bv;
            if (n == 0) { wg0 = pwg0; wg1 = pwg1; wg2 = pwg2; bg = pbg; wv0 = pwv0; wv1 = pwv1; wv2 = pwv2; bv = pbv; }
            else { wg0 = *(const f32x4*)(cw + j); wg1 = *(const f32x4*)(cw + FF2c + j); wg2 = *(const f32x4*)(cw + 2 * FF2c + j); bg = *(const f32x4*)(cb + j);
                   wv0 = *(const f32x4*)(cw + FFc + j); wv1 = *(const f32x4*)(cw + FF2c + FFc + j); wv2 = *(const f32x4*)(cw + 2 * FF2c + FFc + j); bv = *(const f32x4*)(cb + FFc + j); }
#pragma unroll
            for (int ai = 0; ai < 2; ++ai) {
                const int sa = (wr == 1) ? ai : 0, sw = (wr == 1) ? 0 : 1;
                const PG8_LAS f32x4* x63 = (const PG8_LAS f32x4*)(xb + (((((sa * 2 + sw) * 4 + wc) * 2 + 1) * 4 + fq) * 64));
                const PG8_LAS f32x4* x62 = (const PG8_LAS f32x4*)(xb + (((((sa * 2 + sw) * 4 + wc) * 2 + 0) * 4 + fq) * 64));
                const f32x4 g63 = x63[n], v63 = x63[2 + n], g62 = x62[n], v62 = x62[2 + n];
#pragma unroll
                for (int m = 0; m < 4; ++m) {
                    const f32x4 cg = acc[ai][0][m][n], cv = acc[ai][1][m][n];
                    f32x4 qg1, qg2, qv1, qv2;
                    if (m == 0) { qg1 = g63; qv1 = v63; qg2 = (fr == 0) ? g62 : g63; qv2 = (fr == 0) ? v62 : v63; }
                    else {
                        const f32x4 og = acc[ai][0][m > 0 ? m - 1 : 0][n], ov = acc[ai][1][m > 0 ? m - 1 : 0][n];
#pragma unroll
                        for (int e = 0; e < 4; ++e) { qg1[e] = dpp_ror1(og[e]); qg2[e] = dpp_ror2(og[e]); qv1[e] = dpp_ror1(ov[e]); qv2[e] = dpp_ror2(ov[e]); }
                    }
                    u32x2 o;
                    float r[4];
#pragma unroll
                    for (int e = 0; e < 4; ++e) {
                        const float g1 = dpp_shr1(qg1[e], cg[e]), g2 = dpp_shr2(qg2[e], cg[e]), v1 = dpp_shr1(qv1[e], cv[e]), v2 = dpp_shr2(qv2[e], cv[e]);
                        const float ag = bg[e] + wg0[e] * g2 + wg1[e] * g1 + wg2[e] * cg[e];
                        const float av = bv[e] + wv0[e] * v2 + wv1[e] * v1 + wv2[e] * cv[e];
                        r[e] = ag * __builtin_amdgcn_rcpf(1.f + __expf(-ag)) * av;
                    }
                    o.x = cvt_pk_bf16(r[0], r[1]); o.y = cvt_pk_bf16(r[2], r[3]);
                    const bool first2 = (ai == 0 && m == 0) && (wr == 0) && (fr < 2);
                    if (!first2) *(u32x2*)(U + (size_t)(row0 + ai * HALF + m * 16) * FFc + j) = o;
                }
            }
        }
    }
};

template <class Epi, class Sched, bool ALIGN_EPI = false, bool SP2 = false>
__device__ __forceinline__ void gemm_phase(PG8_LAS unsigned char* lds, const Gemm g, const Sched& S, const Epi& E) {
    const int tid = opaque_tid(), wid = __builtin_amdgcn_readfirstlane(tid >> 6), lane = tid & 63, wr = wid >> 2, wc = wid & 3, fr = lane & 15, fq = lane >> 4;
    const int K = g.K, nt = K / BK;
    unsigned voffA[2], voffB[2];
#pragma unroll
    for (int i = 0; i < 2; ++i) { int R, C; stage_rc(tid * 16 + i * 8192, R, C); const int Rb = Epi::PERM ? ((R & ~31) + perm32(R & 31)) : R;
        voffA[i] = (unsigned)(R * K + C) * 2u; voffB[i] = (unsigned)(Rb * K + C) * 2u; }
    const size_t kstep = (size_t)(BK * 2);
    const size_t hstep = (size_t)HALF * K * 2;
    const size_t tstep = 2 * hstep;
    const unsigned ldsw = (unsigned)wid * 1024u;
    const int aoff = lds_byte(wr * 64 + fr, fq * 8), boff = lds_byte(wc * 32 + fr, fq * 8);
#define PG8_SA(b, h) (((b) * 2 + (h)) * HTB)
#define PG8_SB(b, h) ((4 + (b) * 2 + (h)) * HTB)
#define PG8_STAGE(bufoff, gbase, voff) do { _Pragma("unroll") for (int _i = 0; _i < 2; ++_i) \
        __builtin_amdgcn_global_load_lds((const unsigned*)((const char*)(gbase) + (voff)[_i]), (PG8_LAS unsigned*)(lds + (bufoff) + ldsw + _i * 8192), 16, 0, 0); } while (0)
#define PG8_LDA(dst, b, h) do { _Pragma("unroll") for (int m = 0; m < 4; ++m) _Pragma("unroll") for (int k = 0; k < 2; ++k) dst[m][k] = *(const PG8_LAS bf16x8*)(lds + PG8_SA(b, h) + aoff + m * 2048 + k * 1024); } while (0)
#define PG8_LDB(dst, b, h) do { _Pragma("unroll") for (int n = 0; n < 2; ++n) _Pragma("unroll") for (int k = 0; k < 2; ++k) dst[n][k] = *(const PG8_LAS bf16x8*)(lds + PG8_SB(b, h) + boff + n * 2048 + k * 1024); } while (0)
#define PG8_MMA(ai, bj, At, Bt) do { __builtin_amdgcn_s_setprio(1); _Pragma("unroll") for (int m = 0; m < 4; ++m) _Pragma("unroll") for (int n = 0; n < 2; ++n) _Pragma("unroll") for (int k = 0; k < 2; ++k) \
        acc[ai][bj][m][n] = __builtin_amdgcn_mfma_f32_16x16x32_bf16(Bt[n][k], At[m][k], acc[ai][bj][m][n], 0, 0, 0); __builtin_amdgcn_s_setprio(0); } while (0)
#define PG8_WAIT_V(n) asm volatile("s_waitcnt vmcnt(" #n ")" ::: "memory")
#define PG8_WAIT_L(n) asm volatile("s_waitcnt lgkmcnt(" #n ")" ::: "memory")
#define PG8_BAR __builtin_amdgcn_s_barrier()
#define PG8_SCHED __builtin_amdgcn_sched_barrier(0)
    Unit cur, nxt; int ui = 0;
    if (!S.next(0, cur)) return;
    f32x4 acc[2][2][4][2];
#pragma unroll
    for (int a = 0; a < 2; ++a)
#pragma unroll
        for (int b = 0; b < 2; ++b)
#pragma unroll
            for (int m = 0; m < 4; ++m)
#pragma unroll
                for (int n = 0; n < 2; ++n) acc[a][b][m][n] = (f32x4){0.f, 0.f, 0.f, 0.f};
    bf16x8 At[4][2], B0[2][2], B1[2][2];
    const char* cA = (const char*)g.A + (size_t)cur.pm * tstep; const char* cB = (const char*)g.Bt + (size_t)cur.pn * tstep;
    S.a_ready(cur);
    if constexpr (SP2) {
        PG8_STAGE(PG8_SB(0, 0), cB, voffB); PG8_STAGE(PG8_SB(0, 1), cB + hstep, voffB); PG8_STAGE(PG8_SA(0, 0), cA, voffA); PG8_STAGE(PG8_SA(0, 1), cA + hstep, voffA);
        if (wr == 1) PG8_BAR;
        PG8_WAIT_V(2); PG8_BAR;
        PG8_STAGE(PG8_SB(1, 0), cB + kstep, voffB); PG8_STAGE(PG8_SA(1, 0), cA + kstep, voffA); PG8_STAGE(PG8_SB(1, 1), cB + hstep + kstep, voffB);
        PG8_WAIT_V(6); PG8_BAR;
    } else {
        PG8_STAGE(PG8_SB(0, 0), cB, voffB); PG8_STAGE(PG8_SA(0, 0), cA, voffA); PG8_STAGE(PG8_SB(0, 1), cB + hstep, voffB); PG8_STAGE(PG8_SA(0, 1), cA + hstep, voffA);
        if (wr == 1) PG8_BAR;
        PG8_WAIT_V(4); PG8_BAR;
        PG8_STAGE(PG8_SB(1, 0), cB + kstep, voffB); PG8_STAGE(PG8_SA(1, 0), cA + kstep, voffA); PG8_STAGE(PG8_SB(1, 1), cB + hstep + kstep, voffB);
        PG8_WAIT_V(6); PG8_BAR;
    }
    for (;;) {
        const bool has_next = S.next(ui + 1, nxt);
        const char* nA = has_next ? (const char*)g.A + (size_t)nxt.pm * tstep : cA; const char* nB = has_next ? (const char*)g.Bt + (size_t)nxt.pn * tstep : cB;
        for (int t = 0; t < nt; t += 2) {
            const bool last = (t == nt - 2);
            const char* a1 = cA + (size_t)(t + 1) * kstep;
            const char* a2 = last ? nA : cA + (size_t)(t + 2) * kstep; const char* b2 = last ? nB : cB + (size_t)(t + 2) * kstep;
            const char* a3 = a2 + kstep; const char* b3 = b2 + kstep;
            if (last && has_next) S.a_ready(nxt);
            if constexpr (SP2) {
            PG8_LDB(B0, 0, 0); PG8_LDB(B1, 0, 1); PG8_SCHED; PG8_LDA(At, 0, 0); PG8_STAGE(PG8_SA(1, 1), a1 + hstep, voffA);
            PG8_WAIT_V(8); PG8_WAIT_L(0); PG8_BAR; PG8_MMA(0, 0, At, B0); PG8_MMA(0, 1, At, B1); PG8_BAR; PG8_SCHED;
            PG8_LDA(At, 0, 1); PG8_STAGE(PG8_SB(0, 0), b2, voffB); PG8_STAGE(PG8_SB(0, 1), b2 + hstep, voffB); PG8_STAGE(PG8_SA(0, 0), a2, voffA);
            PG8_WAIT_V(8); PG8_WAIT_L(0); PG8_BAR; PG8_MMA(1, 0, At, B0); PG8_MMA(1, 1, At, B1); PG8_BAR; PG8_SCHED;
            PG8_LDB(B0, 1, 0); PG8_LDB(B1, 1, 1); PG8_SCHED; PG8_LDA(At, 1, 0); PG8_STAGE(PG8_SA(0, 1), a2 + hstep, voffA);
            PG8_WAIT_V(8); PG8_WAIT_L(0); PG8_BAR; PG8_MMA(0, 0, At, B0); PG8_MMA(0, 1, At, B1); PG8_BAR; PG8_SCHED;
            PG8_LDA(At, 1, 1); PG8_STAGE(PG8_SB(1, 0), b3, voffB); PG8_STAGE(PG8_SB(1, 1), b3 + hstep, voffB); PG8_STAGE(PG8_SA(1, 0), a3, voffA);
            PG8_WAIT_V(8); PG8_WAIT_L(0); PG8_BAR; PG8_MMA(1, 0, At, B0); PG8_MMA(1, 1, At, B1); PG8_BAR; PG8_SCHED;
            } else {
            PG8_LDB(B0, 0, 0); PG8_SCHED; PG8_LDA(At, 0, 0); PG8_STAGE(PG8_SA(1, 1), a1 + hstep, voffA);
            PG8_WAIT_L(8); PG8_BAR; PG8_WAIT_L(0); PG8_MMA(0, 0, At, B0); PG8_BAR; PG8_SCHED;
            PG8_LDB(B1, 0, 1); PG8_STAGE(PG8_SB(0, 0), b2, voffB);
            PG8_BAR; PG8_WAIT_L(0); PG8_MMA(0, 1, At, B1); PG8_BAR;
            PG8_LDA(At, 0, 1); PG8_STAGE(PG8_SA(0, 0), a2, voffA);
            PG8_BAR; PG8_WAIT_L(0); PG8_MMA(1, 0, At, B0); PG8_BAR; PG8_SCHED;
            PG8_STAGE(PG8_SB(0, 1), b2 + hstep, voffB);
            PG8_WAIT_V(6); PG8_BAR; PG8_MMA(1, 1, At, B1); PG8_BAR;
            PG8_LDB(B0, 1, 0); PG8_SCHED; PG8_LDA(At, 1, 0); PG8_STAGE(PG8_SA(0, 1), a2 + hstep, voffA);
            PG8_WAIT_L(8); PG8_BAR; PG8_WAIT_L(0); PG8_MMA(0, 0, At, B0); PG8_BAR; PG8_SCHED;
            PG8_LDB(B1, 1, 1); PG8_STAGE(PG8_SB(1, 0), b3, voffB);
            PG8_BAR; PG8_WAIT_L(0); PG8_MMA(0, 1, At, B1); PG8_BAR;
            PG8_LDA(At, 1, 1); PG8_STAGE(PG8_SA(1, 0), a3, voffA);
            PG8_BAR; PG8_WAIT_L(0); PG8_MMA(1, 0, At, B0); PG8_BAR; PG8_SCHED;
            PG8_STAGE(PG8_SB(1, 1), b3 + hstep, voffB);
            PG8_WAIT_V(6); PG8_BAR; PG8_MMA(1, 1, At, B1); PG8_BAR;
            }
        }
        if constexpr (ALIGN_EPI) { if (wr == 0) PG8_BAR; }
#ifdef REP_E
        if constexpr (Epi::PERM) { E(acc, cur, wr, wc, fr, fq); asm volatile("" ::: "memory"); }
#endif
        if constexpr (!Epi::AFTER_DRAIN) { E(acc, cur, wr, wc, fr, fq); S.done(cur); }
        if (!has_next) break;
#pragma unroll
        for (int a = 0; a < 2; ++a)
#pragma unroll
            for (int b = 0; b < 2; ++b)
#pragma unroll
                for (int m = 0; m < 4; ++m)
#pragma unroll
                    for (int n = 0; n < 2; ++n) acc[a][b][m][n] = (f32x4){0.f, 0.f, 0.f, 0.f};
        cur = nxt; cA = nA; cB = nB; ++ui;
        if constexpr (ALIGN_EPI) { if (wr == 1) PG8_BAR; }
    }
    PG8_WAIT_V(0);
    if constexpr (!ALIGN_EPI) { if (wr == 0) PG8_BAR; }
    PG8_BAR;
    if constexpr (Epi::AFTER_DRAIN) { E.fused(acc, cur, wr, wc, fr, fq, lds, wid, lane); S.done(cur); }
#undef PG8_SA
#undef PG8_SB
#undef PG8_STAGE
#undef PG8_LDA
#undef PG8_LDB
#undef PG8_MMA
#undef PG8_WAIT_V
#undef PG8_WAIT_L
#undef PG8_BAR
#undef PG8_SCHED
}
}
#define DI __device__ __forceinline__
#define LAS __attribute__((address_space(3)))
typedef unsigned short bf16_t;
typedef short bf16x8 __attribute__((ext_vector_type(8)));
typedef short s16x4 __attribute__((ext_vector_type(4)));
typedef float f32x4 __attribute__((ext_vector_type(4)));
typedef float f32x16 __attribute__((ext_vector_type(16)));
typedef unsigned u32x4 __attribute__((ext_vector_type(4)));
typedef unsigned u32x2 __attribute__((ext_vector_type(2)));
#define MFMA32(a, b, c) __builtin_amdgcn_mfma_f32_32x32x16_bf16((a), (b), (c), 0, 0, 0)

constexpr int T_TOK = 16384, DM = 2048, SEQ = 4096, PIN = 7168, FF = 5632, FF2 = 11264, MODW = 12288;
constexpr float EPS = 1e-6f;
constexpr size_t MiB = 1u << 20;
constexpr size_t WS_MODP = 0, WS_MOD = 6 * MiB, WS_DEC = 7 * MiB, WS_STATS = 8 * MiB;
constexpr size_t WS_W = 16 * MiB;
constexpr size_t WS_WA = WS_W, WS_WO = WS_W + 28 * MiB, WS_WU = WS_WO + 8 * MiB, WS_WD = WS_WU + 44 * MiB;
constexpr size_t WS_HY = 118 * MiB;
constexpr size_t WS_BIG = 182 * MiB;
constexpr size_t WS_XB = WS_BIG;
constexpr size_t WS_Z = WS_BIG + 64 * MiB;
constexpr size_t WS_UT = WS_BIG + 224 * MiB;
constexpr size_t WS_U = 534 * MiB;
constexpr size_t WS_VT = WS_U, WS_ST = WS_U + 32 * MiB;
constexpr size_t WS_END = 710 * MiB;
constexpr int LDS_BYTES = 147456;

struct P {
    const float *x, *c, *ada_w, *ada_b, *mix_norm, *ffn_norm, *par_w_in, *par_w_out, *lb_logits, *hg_out_norm, *sg_w_in, *sg_v_gain, *sg_v_bias, *sg_w_pos, *sg_b_pos, *sg_w_out,
        *ffn_up, *conv_w, *conv_b, *ffn_down, *final_norm;
    float* out; unsigned char* ws;
};

DI unsigned pk2(float lo, float hi) { return pg8::cvt_pk_bf16(lo, hi); }
DI bf16_t f2bf(float x) { return (bf16_t)(pk2(x, 0.f) & 0xffffu); }
DI float bf2f(unsigned v) { return __uint_as_float(v << 16); }
DI float bflo(unsigned w) { return __uint_as_float(w << 16); }
DI float bfhi(unsigned w) { return __uint_as_float(w & 0xffff0000u); }
DI float wave_sum(float v) {
#pragma unroll
    for (int o = 1; o < 64; o <<= 1) v += __shfl_xor(v, o);
    return v;
}
DI int crow(int reg, int h) { return (reg & 3) + 8 * (reg >> 2) + 4 * h; }
DI f32x16 zero16() { f32x16 z;
#pragma unroll
    for (int i = 0; i < 16; ++i) z[i] = 0.f;
    return z; }
DI bf16x8 pack_step(const f32x16& x, int s) {
    u32x4 p; p.x = pk2(x[8 * s], x[8 * s + 1]); p.y = pk2(x[8 * s + 2], x[8 * s + 3]); p.z = pk2(x[8 * s + 4], x[8 * s + 5]); p.w = pk2(x[8 * s + 6], x[8 * s + 7]);
    return __builtin_bit_cast(bf16x8, p);
}

DI void transpose_item(const float* W, int K, int N, bf16_t* WT, LAS float* scr, int item, int lane, bool gv = false) {
    const int nblk = N / 32, kb = item / nblk, nb = item % nblk, k0 = 64 * kb, n0 = 32 * nb;
    const int nd0 = !gv ? n0 : (n0 < FF ? 256 * (n0 >> 7) + (n0 & 127) : 256 * ((n0 - FF) >> 7) + 128 + ((n0 - FF) & 127));
#pragma unroll 8
    for (int i = 0; i < 32; ++i) { const int kk = 2 * i + (lane >> 5); scr[kk * 33 + (lane & 31)] = W[(size_t)(k0 + kk) * N + n0 + (lane & 31)]; }
    asm volatile("s_waitcnt lgkmcnt(0)" ::: "memory");
    const int c = lane & 7;
#pragma unroll
    for (int j = 0; j < 4; ++j) { const int n = (lane >> 3) + 8 * j; const LAS float* s = scr + (8 * c) * 33 + n;
        u32x4 o; o.x = pk2(s[0 * 33], s[1 * 33]); o.y = pk2(s[2 * 33], s[3 * 33]); o.z = pk2(s[4 * 33], s[5 * 33]); o.w = pk2(s[6 * 33], s[7 * 33]);
        *(u32x4*)(WT + (size_t)(nd0 + n) * K + k0 + 8 * c) = o; }
    asm volatile("s_waitcnt lgkmcnt(0)" ::: "memory");
}
DI void convert_weights(const P& p, int layer, LAS unsigned char* L, int gw, int ngw, int wave, int lane) {
    LAS float* scr = (LAS float*)(L + wave * 16384);
    const float* w0 = layer ? p.sg_w_in : p.par_w_in; const int n0 = layer ? 4096 : PIN;
    const float* w1 = layer ? p.sg_w_out : p.par_w_out;
    const float* w2 = p.ffn_up + (size_t)layer * DM * FF2;
    const float* w3 = p.ffn_down + (size_t)layer * FF * DM;
    const int I0 = 32 * (n0 / 32), I1 = 32 * 64, I2 = 32 * (FF2 / 32), I3 = (FF / 64) * 64;
    for (int it = gw; it < I0 + I1 + I2 + I3; it += ngw) {
        int r = it;
        if (r < I0) { transpose_item(w0, DM, n0, (bf16_t*)(p.ws + WS_WA), scr, r, lane); continue; } r -= I0;
        if (r < I1) { transpose_item(w1, DM, DM, (bf16_t*)(p.ws + WS_WO), scr, r, lane); continue; } r -= I1;
        if (r < I2) { transpose_item(w2, DM, FF2, (bf16_t*)(p.ws + WS_WU), scr, r, lane, true); continue; } r -= I2;
        transpose_item(w3, FF, DM, (bf16_t*)(p.ws + WS_WD), scr, r, lane);
    }
}
DI void ada_partials(const P& p, LAS unsigned char* L) {
    LAS float* condl = (LAS float*)(L + 8 * 16384);
    float* modp = (float*)(p.ws + WS_MODP);
    const int tid = opaque_tid();
    for (int item = blockIdx.x; item < 768; item += gridDim.x) {
        const int l = item / 384, r = item % 384, cb = r / 16, ks = r % 16;
        __syncthreads();
        { const int b = tid >> 7, k = tid & 127; const float cv = p.c[b * DM + ks * 128 + k]; condl[tid] = cv * __builtin_amdgcn_rcpf(1.f + __expf(-cv)); }
        __syncthreads();
        const int col = cb * 512 + tid;
        const float* w = p.ada_w + ((size_t)l * DM + ks * 128) * MODW + col;
        float a0 = 0.f, a1 = 0.f, a2 = 0.f, a3 = 0.f;
#pragma unroll 8
        for (int k = 0; k < 128; ++k) { const float wv = w[(size_t)k * MODW]; a0 += condl[k] * wv; a1 += condl[128 + k] * wv; a2 += condl[256 + k] * wv; a3 += condl[384 + k] * wv; }
        float* o = modp + ((size_t)(ks * 2 + l) * 4) * MODW + col;
        o[0] = a0; o[MODW] = a1; o[2 * MODW] = a2; o[3 * MODW] = a3;
    }
}
DI void mod_reduce(const P& p) {
    const float* modp = (const float*)(p.ws + WS_MODP); float* mod = (float*)(p.ws + WS_MOD);
    for (int idx = blockIdx.x * 512 + opaque_tid(); idx < 2 * 4 * MODW; idx += gridDim.x * 512) {
        const int l = idx / (4 * MODW), col = idx % MODW; float s = p.ada_b[l * MODW + col];
#pragma unroll
        for (int ks = 0; ks < 16; ++ks) s += modp[(size_t)ks * (2 * 4 * MODW) + idx];
        mod[idx] = s;
    }
}
DI void norm_rows(const float* X, const float* gain, const float* sh, const float* sc, bf16_t* H, int gw, int ngw, int lane) {
    for (int m = gw; m < T_TOK; m += ngw) {
        const int b = m >> 12;
        const f32x4* xr = (const f32x4*)(X + (size_t)m * DM) + lane;
        f32x4 v[8]; float s = 0.f;
#pragma unroll
        for (int j = 0; j < 8; ++j) { v[j] = xr[64 * j]; s += (v[j].x * v[j].x + v[j].y * v[j].y) + (v[j].z * v[j].z + v[j].w * v[j].w); }
        const float rstd = rsqrtf(wave_sum(s) * (1.f / DM) + EPS);
        const f32x4* gp = (const f32x4*)gain + lane; const f32x4* scp = (const f32x4*)(sc + (size_t)b * MODW) + lane; const f32x4* shp = (const f32x4*)(sh + (size_t)b * MODW) + lane;
        u32x2* o = (u32x2*)(H + (size_t)m * DM) + lane;
#pragma unroll
        for (int j = 0; j < 8; ++j) { const f32x4 r = v[j] * rstd * gp[64 * j] * (scp[64 * j] + 1.0f) + shp[64 * j]; u32x2 w; w.x = pk2(r.x, r.y); w.y = pk2(r.z, r.w); o[64 * j] = w; }
    }
}
DI void final_norm_rows(float* X, const float* gain, int gw, int ngw, int lane) {
    for (int m = gw; m < T_TOK; m += ngw) {
        f32x4* xr = (f32x4*)(X + (size_t)m * DM) + lane;
        f32x4 v[8]; float s = 0.f;
#pragma unroll
        for (int j = 0; j < 8; ++j) { v[j] = xr[64 * j]; s += (v[j].x * v[j].x + v[j].y * v[j].y) + (v[j].z * v[j].z + v[j].w * v[j].w); }
        const float rstd = rsqrtf(wave_sum(s) * (1.f / DM) + EPS);
        const f32x4* gp = (const f32x4*)gain + lane;
#pragma unroll
        for (int j = 0; j < 8; ++j) xr[64 * j] = v[j] * rstd * gp[64 * j];
    }
}
DI void unpack8(const u32x4 w, float (&f)[8]) { f[0] = bflo(w.x); f[1] = bfhi(w.x); f[2] = bflo(w.y); f[3] = bfhi(w.y); f[4] = bflo(w.z); f[5] = bfhi(w.z); f[6] = bflo(w.w); f[7] = bfhi(w.w); }
DI void ld8f(const float* p, float (&f)[8]) { const f32x4 a = *(const f32x4*)p, b = *(const f32x4*)(p + 4); f[0] = a.x; f[1] = a.y; f[2] = a.z; f[3] = a.w; f[4] = b.x; f[5] = b.y; f[6] = b.z; f[7] = b.w; }
DI void conv_act(const bf16_t* A, const float* cw, const float* cb, bf16_t* U) {
    const int total = (T_TOK / 8) * (FF / 8);
    for (int it = blockIdx.x * 512 + opaque_tid(); it < total; it += gridDim.x * 512) {
        const int j8 = it % (FF / 8), tb = it / (FF / 8), j = j8 * 8, t0 = tb * 8;
        float wg0[8], wg1[8], wg2[8], wv0[8], wv1[8], wv2[8], bg[8], bv[8];
        ld8f(cw + j, wg0); ld8f(cw + FF2 + j, wg1); ld8f(cw + 2 * FF2 + j, wg2);
        ld8f(cw + FF + j, wv0); ld8f(cw + FF2 + FF + j, wv1); ld8f(cw + 2 * FF2 + FF + j, wv2);
        ld8f(cb + j, bg); ld8f(cb + FF + j, bv);
        float g2[8], g1[8], v2[8], v1[8];
        if ((t0 & (SEQ - 1)) == 0) {
#pragma unroll
            for (int e = 0; e < 8; ++e) { g2[e] = 0.f; g1[e] = 0.f; v2[e] = 0.f; v1[e] = 0.f; }
        } else {
            unpack8(*(const u32x4*)(A + (size_t)(t0 - 2) * FF2 + j), g2); unpack8(*(const u32x4*)(A + (size_t)(t0 - 1) * FF2 + j), g1);
            unpack8(*(const u32x4*)(A + (size_t)(t0 - 2) * FF2 + FF + j), v2); unpack8(*(const u32x4*)(A + (size_t)(t0 - 1) * FF2 + FF + j), v1);
        }
#pragma unroll
        for (int i = 0; i < 8; ++i) {
            float g0[8], v0[8];
            unpack8(*(const u32x4*)(A + (size_t)(t0 + i) * FF2 + j), g0); unpack8(*(const u32x4*)(A + (size_t)(t0 + i) * FF2 + FF + j), v0);
            float o[8];
#pragma unroll
            for (int e = 0; e < 8; ++e) {
                const float ag = bg[e] + wg0[e] * g2[e] + wg1[e] * g1[e] + wg2[e] * g0[e];
                const float av = bv[e] + wv0[e] * v2[e] + wv1[e] * v1[e] + wv2[e] * v0[e];
                o[e] = ag * __builtin_amdgcn_rcpf(1.f + __expf(-ag)) * av;
                g2[e] = g1[e]; g1[e] = g0[e]; v2[e] = v1[e]; v1[e] = v0[e];
            }
            u32x4 w; w.x = pk2(o[0], o[1]); w.y = pk2(o[2], o[3]); w.z = pk2(o[4], o[5]); w.w = pk2(o[6], o[7]);
            *(u32x4*)(U + (size_t)(t0 + i) * FF + j) = w;
        }
    }
}
DI void conv_fixup(const float* SB, const float* cw, const float* cb, bf16_t* U) {
    for (int it = blockIdx.x * 512 + opaque_tid(); it < 64 * (FF / 4); it += gridDim.x * 512) {
        const int pm = it / (FF / 4), j = (it % (FF / 4)) * 4;
        const int tc = 256 * (j >> 7) + (j & 127);
        const f32x4 zero4 = {0.f, 0.f, 0.f, 0.f};
        const bool head = (pm & 15) == 0;
        const float* s0 = SB + (size_t)(pm * 4) * FF2 + tc; const float* sp = SB + (size_t)((pm - 1) * 4) * FF2 + tc;
        const f32x4 g0 = *(const f32x4*)(s0), g1 = *(const f32x4*)(s0 + FF2), v0 = *(const f32x4*)(s0 + 128), v1 = *(const f32x4*)(s0 + FF2 + 128);
        const f32x4 gA = head ? zero4 : *(const f32x4*)(sp + 2 * FF2), gB = head ? zero4 : *(const f32x4*)(sp + 3 * FF2);
        const f32x4 vA = head ? zero4 : *(const f32x4*)(sp + 2 * FF2 + 128), vB = head ? zero4 : *(const f32x4*)(sp + 3 * FF2 + 128);
        const f32x4 wg0 = *(const f32x4*)(cw + j), wg1 = *(const f32x4*)(cw + FF2 + j), wg2 = *(const f32x4*)(cw + 2 * FF2 + j), bg = *(const f32x4*)(cb + j);
        const f32x4 wv0 = *(const f32x4*)(cw + FF + j), wv1 = *(const f32x4*)(cw + FF2 + FF + j), wv2 = *(const f32x4*)(cw + 2 * FF2 + FF + j), bv = *(const f32x4*)(cb + FF + j);
        const f32x4 ag0 = bg + wg0 * gA + wg1 * gB + wg2 * g0, av0 = bv + wv0 * vA + wv1 * vB + wv2 * v0;
        const f32x4 ag1 = bg + wg0 * gB + wg1 * g0 + wg2 * g1, av1 = bv + wv0 * vB + wv1 * v0 + wv2 * v1;
        float r0[4], r1[4];
#pragma unroll
        for (int e = 0; e < 4; ++e) { r0[e] = ag0[e] * __builtin_amdgcn_rcpf(1.f + __expf(-ag0[e])) * av0[e]; r1[e] = ag1[e] * __builtin_amdgcn_rcpf(1.f + __expf(-ag1[e])) * av1[e]; }
        u32x2 o; o.x = pk2(r0[0], r0[1]); o.y = pk2(r0[2], r0[3]); *(u32x2*)(U + (size_t)(pm * 256) * FF + j) = o;
        o.x = pk2(r1[0], r1[1]); o.y = pk2(r1[2], r1[3]); *(u32x2*)(U + (size_t)(pm * 256 + 1) * FF + j) = o;
    }
}
DI void v_transpose(const bf16_t* PROJ, bf16_t* VT, LAS unsigned char* L) {
    const int tid = opaque_tid();
    for (int item = blockIdx.x; item < 1024; item += gridDim.x) {
        const int bh = item >> 5, sb = item & 31, b = bh >> 3, hh = bh & 7;
        __syncthreads();
#pragma unroll
        for (int j = 0; j < 4; ++j) { const int c = tid + 512 * j, s = c >> 4, d8 = c & 15;
            const u32x4 v = *(const u32x4*)(PROJ + ((size_t)b * SEQ + sb * 128 + s) * PIN + 2048 + hh * 128 + d8 * 8);
            *(LAS u32x4*)(L + s * 272 + d8 * 16) = v; }
        __syncthreads();
#pragma unroll
        for (int j = 0; j < 4; ++j) { const int c = tid + 512 * j, d = c >> 4, s8 = c & 15;
            unsigned e[8];
#pragma unroll
            for (int i = 0; i < 8; ++i) e[i] = *(const LAS bf16_t*)(L + (s8 * 8 + i) * 272 + d * 2);
            u32x4 o; o.x = e[0] | (e[1] << 16); o.y = e[2] | (e[3] << 16); o.z = e[4] | (e[5] << 16); o.w = e[6] | (e[7] << 16);
            *(u32x4*)(VT + ((size_t)bh * 128 + d) * SEQ + sb * 128 + s8 * 8) = o; }
    }
}
DI void hg_gates(const LAS unsigned char* rawf, const float* lbl, int part, int hh, int d, float (&G)[16], float (&kk)[16]) {
    const float l0 = lbl[hh * 128 + d], l1 = lbl[1024 + hh * 128 + d]; const float lb = __builtin_amdgcn_rcpf(1.f + __expf(l1 - l0));
    float run = 0.f;
#pragma unroll
    for (int i = 0; i < 16; ++i) {
        const float fl = bf2f(*(const LAS bf16_t*)(rawf + (16 * part + i) * 272 + d * 2));
        const float sig = __builtin_amdgcn_rcpf(1.f + __expf(-fl)); const float f = lb + (1.f - lb) * sig;
        kk[i] = (1.f - lb) * (1.f - sig); run += __builtin_amdgcn_logf(f) * 0.69314718056f; G[i] = run;
    }
}
DI void hg_raw_load(const bf16_t* PROJ, int ch, int colbase, unsigned roff, u32x4 (&rg)[2]) {
    const int bh = ch >> 6, n = ch & 63, b = bh >> 3, hh = bh & 7;
    const bf16_t* src = PROJ + ((size_t)b * SEQ + n * 64) * PIN + colbase + hh * 128;
    rg[0] = *(const u32x4*)(src + roff); rg[1] = *(const u32x4*)(src + (size_t)32 * PIN + roff);
}
DI void hg_raw_store(LAS unsigned char* img, int tid, const u32x4 (&rg)[2]) {
    LAS unsigned char* wp = img + (tid >> 4) * 272 + (tid & 15) * 16;
    *(LAS u32x4*)wp = rg[0]; *(LAS u32x4*)(wp + 32 * 272) = rg[1];
}
DI void hg_col16(const LAS unsigned char* img, int part, int d, u32x4& a, u32x4& c) {
    unsigned e[16];
#pragma unroll
    for (int i = 0; i < 16; ++i) e[i] = *(const LAS bf16_t*)(img + (16 * part + i) * 272 + d * 2);
    a.x = e[0] | (e[1] << 16); a.y = e[2] | (e[3] << 16); a.z = e[4] | (e[5] << 16); a.w = e[6] | (e[7] << 16);
    c.x = e[8] | (e[9] << 16); c.y = e[10] | (e[11] << 16); c.z = e[12] | (e[13] << 16); c.w = e[14] | (e[15] << 16);
}
DI void hg_phase_a(const P& p, const bf16_t* PROJ, float* UT, float* DEC, LAS unsigned char* L) {
    const int tid = opaque_tid(), w = __builtin_amdgcn_readfirstlane(tid >> 6), lane = tid & 63, r = lane & 31, lh = lane >> 5;
    LAS unsigned char* kendT = L; LAS unsigned char* vT = L + 18432; LAS float* psum = (LAS float*)(L + 36864);
    LAS unsigned char* rawf = L + 40960; LAS unsigned char* rawv = L + 40960 + 17408;
    const int d = tid & 127, part = tid >> 7;
    const unsigned roff = (unsigned)((tid >> 4) * PIN + (tid & 15) * 8);
    u32x4 rf[2], rv[2];
    if ((int)blockIdx.x < 2048) { hg_raw_load(PROJ, blockIdx.x, 4096, roff, rf); hg_raw_load(PROJ, blockIdx.x, 5120, roff, rv); }
    for (int ch = blockIdx.x; ch < 2048; ch += gridDim.x) {
        const int bh = ch >> 6, hh = bh & 7;
        __syncthreads();
        hg_raw_store(rawf, tid, rf); hg_raw_store(rawv, tid, rv);
        if (ch + (int)gridDim.x < 2048) { hg_raw_load(PROJ, ch + gridDim.x, 4096, roff, rf); hg_raw_load(PROJ, ch + gridDim.x, 5120, roff, rv); }
        __syncthreads();
        float G[16], kk[16];
        hg_gates(rawf, p.lb_logits, part, hh, d, G, kk);
        psum[part * 128 + d] = G[15];
        { u32x4 a, c; hg_col16(rawv, part, d, a, c); *(LAS u32x4*)(vT + d * 144 + part * 32) = a; *(LAS u32x4*)(vT + d * 144 + part * 32 + 16) = c; }
        __syncthreads();
        float off = 0.f, tot = 0.f;
#pragma unroll
        for (int q = 0; q < 4; ++q) { const float v = psum[q * 128 + d]; tot += v; off += (q < part) ? v : 0.f; }
        { float ke[16];
#pragma unroll
          for (int i = 0; i < 16; ++i) ke[i] = kk[i] * __expf(tot - (off + G[i]));
          u32x4 a, c; a.x = pk2(ke[0], ke[1]); a.y = pk2(ke[2], ke[3]); a.z = pk2(ke[4], ke[5]); a.w = pk2(ke[6], ke[7]);
          c.x = pk2(ke[8], ke[9]); c.y = pk2(ke[10], ke[11]); c.z = pk2(ke[12], ke[13]); c.w = pk2(ke[14], ke[15]);
          *(LAS u32x4*)(kendT + d * 144 + part * 32) = a; *(LAS u32x4*)(kendT + d * 144 + part * 32 + 16) = c; }
        if (part == 0) DEC[(size_t)ch * 128 + d] = __expf(tot);
        __syncthreads();
        const int dvt = w >> 1, dkt0 = (w & 1) * 2;
        f32x16 acc0 = zero16(), acc1 = zero16();
#pragma unroll
        for (int ks = 0; ks < 4; ++ks) {
            const bf16x8 a = *(const LAS bf16x8*)(vT + (32 * dvt + r) * 144 + (16 * ks + 8 * lh) * 2);
            const bf16x8 b0 = *(const LAS bf16x8*)(kendT + (32 * dkt0 + r) * 144 + (16 * ks + 8 * lh) * 2);
            const bf16x8 b1 = *(const LAS bf16x8*)(kendT + (32 * (dkt0 + 1) + r) * 144 + (16 * ks + 8 * lh) * 2);
            acc0 = MFMA32(a, b0, acc0); acc1 = MFMA32(a, b1, acc1);
        }
        float* o = UT + (size_t)ch * 16384;
#pragma unroll
        for (int reg = 0; reg < 16; ++reg) { const int dv = 32 * dvt + crow(reg, lh); o[dv * 128 + 32 * dkt0 + r] = acc0[reg]; o[dv * 128 + 32 * (dkt0 + 1) + r] = acc1[reg]; }
    }
}
DI void hg_phase_b(const float* UT, const float* DEC, bf16_t* ST) {
    for (int idx = blockIdx.x * 512 + opaque_tid(); idx < 32 * 4096; idx += gridDim.x * 512) {
        const int bh = idx >> 12, rem = idx & 4095, dv = rem >> 5, dk4 = (rem & 31) * 4;
        f32x4 st = {0.f, 0.f, 0.f, 0.f};
#pragma unroll 4
        for (int n = 0; n < 64; ++n) {
            const size_t ch = (size_t)bh * 64 + n;
            u32x2 w; w.x = pk2(st.x, st.y); w.y = pk2(st.z, st.w);
            *(u32x2*)(ST + ch * 16384 + dv * 128 + dk4) = w;
            const f32x4 u = *(const f32x4*)(UT + ch * 16384 + dv * 128 + dk4), dc = *(const f32x4*)(DEC + ch * 128 + dk4);
            st = dc * st + u;
        }
    }
}
DI void hg_phase_c(const P& p, const bf16_t* PROJ, const bf16_t* ST, bf16_t* Y, LAS unsigned char* L, unsigned* qcnt) {
    const int tid = opaque_tid(), w = __builtin_amdgcn_readfirstlane(tid >> 6), lane = tid & 63, r = lane & 31, lh = lane >> 5;
    LAS unsigned char* qd = L; LAS unsigned char* ki = L + 17408; LAS unsigned char* vT = L + 34816; LAS float* psum = (LAS float*)(L + 52224); LAS float* rp = (LAS float*)(L + 54272);
    LAS unsigned char* rawf = L + 57344; LAS unsigned char* rawv = rawf + 17408; LAS unsigned char* rawq = rawv + 17408;
    const int d = tid & 127, part = tid >> 7;
    const unsigned roff = (unsigned)((tid >> 4) * PIN + (tid & 15) * 8);
    u32x4 rf[2], rv[2], rq[2];
    LAS unsigned* qs = (LAS unsigned*)(L + 139424);
    __syncthreads();
    if (tid == 0) qs[0] = __hip_atomic_fetch_add(qcnt, 1u, __ATOMIC_RELAXED, __HIP_MEMORY_SCOPE_AGENT);
    __syncthreads();
    int ch = (int)qs[0], par = 0;
    if (ch < 2048) { hg_raw_load(PROJ, ch, 4096, roff, rf); hg_raw_load(PROJ, ch, 5120, roff, rv); hg_raw_load(PROJ, ch, 3072, roff, rq); }
    while (ch < 2048) {
        const int bh = ch >> 6, n = ch & 63, b = bh >> 3, hh = bh & 7;
        if (tid == 0) qs[par ^ 1] = __hip_atomic_fetch_add(qcnt, 1u, __ATOMIC_RELAXED, __HIP_MEMORY_SCOPE_AGENT);
        __syncthreads();
        const int nxt = (int)qs[par ^ 1];
        hg_raw_store(rawf, tid, rf); hg_raw_store(rawv, tid, rv); hg_raw_store(rawq, tid, rq);
        if (nxt < 2048) { hg_raw_load(PROJ, nxt, 4096, roff, rf); hg_raw_load(PROJ, nxt, 5120, roff, rv); hg_raw_load(PROJ, nxt, 3072, roff, rq); }
        __syncthreads();
        const int dt = w & 3, tt = w >> 2;
        bf16x8 stf[8];
        { const bf16_t* STc = ST + (size_t)ch * 16384 + (32 * dt + r) * 128 + 8 * lh;
#pragma unroll
          for (int ks = 0; ks < 8; ++ks) stf[ks] = *(const bf16x8*)(STc + 16 * ks); }
        const size_t trow = (size_t)b * SEQ + n * 64 + 32 * tt + r;
        u32x2 ggv[4]; f32x4 ogv[4];
#pragma unroll
        for (int g4 = 0; g4 < 4; ++g4) { const int dv0 = 32 * dt + 8 * g4 + 4 * lh; ggv[g4] = *(const u32x2*)(PROJ + trow * PIN + 6144 + hh * 128 + dv0); ogv[g4] = *(const f32x4*)(p.hg_out_norm + hh * 128 + dv0); }
        float G[16], kk[16];
        hg_gates(rawf, p.lb_logits, part, hh, d, G, kk);
        psum[part * 128 + d] = G[15];
        { u32x4 a, c; hg_col16(rawv, part, d, a, c);
          u32x2 t2; t2.x = a.x; t2.y = a.y; *(LAS u32x2*)(vT + d * 136 + part * 32) = t2; t2.x = a.z; t2.y = a.w; *(LAS u32x2*)(vT + d * 136 + part * 32 + 8) = t2;
          t2.x = c.x; t2.y = c.y; *(LAS u32x2*)(vT + d * 136 + part * 32 + 16) = t2; t2.x = c.z; t2.y = c.w; *(LAS u32x2*)(vT + d * 136 + part * 32 + 24) = t2; }
        float qs[16];
#pragma unroll
        for (int i = 0; i < 16; ++i) { const float ql = bf2f(*(const LAS bf16_t*)(rawq + (16 * part + i) * 272 + d * 2)); qs[i] = ql * __builtin_amdgcn_rcpf(1.f + __expf(-ql)); }
        __syncthreads();
        float off = 0.f;
#pragma unroll
        for (int q = 0; q < 4; ++q) { const float v = psum[q * 128 + d]; off += (q < part) ? v : 0.f; }
#pragma unroll
        for (int i = 0; i < 16; ++i) { const float g = off + G[i];
            *(LAS bf16_t*)(qd + (16 * part + i) * 272 + d * 2) = f2bf(qs[i] * __expf(g));
            *(LAS bf16_t*)(ki + (16 * part + i) * 272 + d * 2) = f2bf(kk[i] * __expf(-g)); }
        __syncthreads();
        bf16x8 qfr[8];
#pragma unroll
        for (int ks = 0; ks < 8; ++ks) qfr[ks] = *(const LAS bf16x8*)(qd + (32 * tt + r) * 272 + (16 * ks + 8 * lh) * 2);
        f32x16 O = zero16();
#pragma unroll
        for (int st = 0; st < 2; ++st) {
            if (st <= tt) {
                f32x16 X = zero16();
#pragma unroll
                for (int ks = 0; ks < 8; ++ks) { const bf16x8 a = *(const LAS bf16x8*)(ki + (32 * st + r) * 272 + (16 * ks + 8 * lh) * 2); X = MFMA32(a, qfr[ks], X); }
                if (st == tt) {
#pragma unroll
                    for (int reg = 0; reg < 16; ++reg) X[reg] = (crow(reg, lh) > r) ? 0.f : X[reg];
                }
#pragma unroll
                for (int sp = 0; sp < 2; ++sp) {
                    const bf16x8 pf = pack_step(X, sp);
                    const s16x4 lo = *(const LAS s16x4*)(vT + (32 * dt + r) * 136 + (32 * st + 16 * sp + 4 * lh) * 2);
                    const s16x4 hi = *(const LAS s16x4*)(vT + (32 * dt + r) * 136 + (32 * st + 16 * sp + 4 * lh) * 2 + 16);
                    O = MFMA32(__builtin_shufflevector(lo, hi, 0, 1, 2, 3, 4, 5, 6, 7), pf, O);
                }
            }
        }
#pragma unroll
        for (int ks = 0; ks < 8; ++ks) O = MFMA32(stf[ks], qfr[ks], O);
        float ss = 0.f;
#pragma unroll
        for (int reg = 0; reg < 16; ++reg) ss += O[reg] * O[reg];
        ss += __shfl_xor(ss, 32);
        if (lh == 0) rp[dt * 64 + 32 * tt + r] = ss;
        __syncthreads();
        const float tot = (rp[32 * tt + r] + rp[64 + 32 * tt + r]) + (rp[128 + 32 * tt + r] + rp[192 + 32 * tt + r]);
        const float rstd = rsqrtf(tot * (1.f / 128.f) + EPS);
#pragma unroll
        for (int g4 = 0; g4 < 4; ++g4) {
            const int dv0 = 32 * dt + 8 * g4 + 4 * lh;
            const u32x2 gg = ggv[g4];
            const f32x4 og = ogv[g4];
            const float g0 = bflo(gg.x), g1 = bfhi(gg.x), g2 = bflo(gg.y), g3 = bfhi(gg.y);
            const float o0 = O[4 * g4] * rstd * og.x * (g0 * __builtin_amdgcn_rcpf(1.f + __expf(-g0))), o1 = O[4 * g4 + 1] * rstd * og.y * (g1 * __builtin_amdgcn_rcpf(1.f + __expf(-g1)));
            const float o2 = O[4 * g4 + 2] * rstd * og.z * (g2 * __builtin_amdgcn_rcpf(1.f + __expf(-g2))), o3 = O[4 * g4 + 3] * rstd * og.w * (g3 * __builtin_amdgcn_rcpf(1.f + __expf(-g3)));
            u32x2 wv; wv.x = pk2(o0, o1); wv.y = pk2(o2, o3);
            *(u32x2*)(Y + trow * DM + 1024 + hh * 128 + dv0) = wv;
        }
        ch = nxt; par ^= 1;
    }
}
template <bool DIAG> DI void sb_elem(f32x16& X, float& run, int tr, bool lh0) {
    const float scale2 = 0.08838834764831845f * 1.4426950408889634f;
    f32x16 KP; float gp[4], pg[4];
#pragma unroll
    for (int g = 0; g < 4; ++g) {
        float a0 = 1.f;
#pragma unroll
        for (int i = 0; i < 4; ++i) { const int reg = 4 * g + i;
            const float z2 = X[reg] * scale2; const float e = __builtin_amdgcn_exp2f(-__builtin_fabsf(z2)); const float inv = __builtin_amdgcn_rcpf(1.f + e);
            float keep = (z2 >= 0.f) ? e * inv : inv;
            if (DIAG) keep = (8 * g + i < tr) ? keep : 1.f;
            KP[reg] = keep; a0 *= keep; }
        gp[g] = a0;
    }
#pragma unroll
    for (int g = 0; g < 4; ++g) pg[g] = __shfl_xor(gp[g], 32);
#pragma unroll
    for (int g = 3; g >= 0; --g) {
        float c = lh0 ? run * pg[g] : run;
#pragma unroll
        for (int i = 3; i >= 0; --i) { const int reg = 4 * g + i; const float cn = c * KP[reg]; X[reg] = c - cn; c = cn; }
        run *= gp[g] * pg[g];
    }
}
DI void attn_phase(const bf16_t* PROJ, const bf16_t* VT, bf16_t* Y, LAS unsigned char* L, unsigned* qcnt) {
    const int tid = opaque_tid(), w = __builtin_amdgcn_readfirstlane(tid >> 6), lane = tid & 63, r = lane & 31, lh = lane >> 5;
    constexpr int ATT_BUF = 34816;
    LAS unsigned char* Kt = L; LAS unsigned char* Vt = L + 17408; LAS unsigned char* Qs = L + 2 * ATT_BUF;
    const unsigned koff = (unsigned)((tid >> 4) * PIN + (tid & 15) * 8), voff = (unsigned)((tid >> 3) * SEQ + (tid & 7) * 8);
    const unsigned yoff = (unsigned)((32 * w + r) * DM + 4 * lh);
    const float lhm = lh == 0 ? 1.f : 0.f;
    LAS unsigned* qslot = (LAS unsigned*)(L + 139392);
    for (;;) {
        {
            __syncthreads();
            if (tid == 0) *qslot = __hip_atomic_fetch_add(qcnt, 1u, __ATOMIC_RELAXED, __HIP_MEMORY_SCOPE_AGENT);
            __syncthreads();
            const int unit = (int)*qslot;
            if (unit >= 512) break;
            const int qb = 15 - (unit >> 5), bh = unit & 31, b = bh >> 3, hh = bh & 7, q0 = qb * 256;
            const size_t rowb = (size_t)b * SEQ;
            const int t = q0 + 32 * w + r;
            { const bf16_t* qp = PROJ + (rowb + q0) * PIN + hh * 128; LAS unsigned char* qwr = Qs + (tid >> 4) * 272 + (tid & 15) * 16;
#pragma unroll
              for (int j = 0; j < 8; ++j) *(LAS u32x4*)(qwr + j * 32 * 272) = *(const u32x4*)(qp + (size_t)j * 32 * PIN + koff); }
            const LAS unsigned char* qrd = Qs + (32 * w + r) * 272 + lh * 16;
            f32x16 O0 = zero16(), O1 = zero16(), O2 = zero16(), O3 = zero16();
            float R = 1.f;
            const int nkt = 4 * qb + 4;
            u32x4 kreg[2], vreg[2];
            const bf16_t* kb0 = PROJ + rowb * PIN + 1024 + hh * 128; const bf16_t* vb0 = VT + (size_t)bh * 128 * SEQ;
            LAS unsigned char* kwr = Kt + (tid >> 4) * 272 + (tid & 15) * 16; LAS unsigned char* vwr = Vt + (tid >> 3) * 136 + (tid & 7) * 16;
#define ATT_LOAD(ktile) { const bf16_t* kb = kb0 + (size_t)(64 * (ktile)) * PIN; const bf16_t* vb = vb0 + 64 * (ktile); \
              kreg[0] = *(const u32x4*)(kb + koff); kreg[1] = *(const u32x4*)(kb + 32 * PIN + koff); \
              vreg[0] = *(const u32x4*)(vb + voff); vreg[1] = *(const u32x4*)(vb + 64 * SEQ + voff); }
#define ATT_WRITE(bo) { *(LAS u32x4*)(kwr + (bo)) = kreg[0]; *(LAS u32x4*)(kwr + (bo) + 32 * 272) = kreg[1]; \
              u32x2 lo, hi; lo.x = vreg[0].x; lo.y = vreg[0].y; hi.x = vreg[0].z; hi.y = vreg[0].w; *(LAS u32x2*)(vwr + (bo)) = lo; *(LAS u32x2*)(vwr + (bo) + 8) = hi; \
              lo.x = vreg[1].x; lo.y = vreg[1].y; hi.x = vreg[1].z; hi.y = vreg[1].w; *(LAS u32x2*)(vwr + (bo) + 64 * 136) = lo; *(LAS u32x2*)(vwr + (bo) + 64 * 136 + 8) = hi; }
            ATT_LOAD(nkt - 1)
            ATT_WRITE(0)
            ATT_LOAD(nkt - 2)
            __syncthreads();
            int bo = 0; bool walive = true;
            for (int kt = nkt - 1; kt >= 0; --kt, bo ^= ATT_BUF) {
                if (64 * kt <= q0 + 32 * w + 30 && walive) {
                    float run = R;
#pragma unroll
                    for (int st = 1; st >= 0; --st) {
                        f32x16 X = zero16();
#pragma unroll
                        for (int ks = 0; ks < 8; ++ks) {
                            const bf16x8 a = *(const LAS bf16x8*)(Kt + bo + (32 * st + r) * 272 + (16 * ks + 8 * lh) * 2);
                            const bf16x8 qv = *(const LAS bf16x8*)(qrd + 32 * ks);
                            X = MFMA32(a, qv, X);
                        }
                        sb_elem<true>(X, run, t - (64 * kt + 32 * st + 4 * lh), lh == 0);
#pragma unroll
                        for (int sp = 0; sp < 2; ++sp) {
                            const bf16x8 pf = pack_step(X, sp);
                            const int so = (32 * st + 16 * sp + 4 * lh) * 2;
#define ATT_PV(Od, dt) { const s16x4 lo = *(const LAS s16x4*)(Vt + bo + (32 * dt + r) * 136 + so); const s16x4 hi = *(const LAS s16x4*)(Vt + bo + (32 * dt + r) * 136 + so + 16); \
                         Od = MFMA32(__builtin_shufflevector(lo, hi, 0, 1, 2, 3, 4, 5, 6, 7), pf, Od); }
                            ATT_PV(O0, 0) ATT_PV(O1, 1) ATT_PV(O2, 2) ATT_PV(O3, 3)
#undef ATT_PV
                        }
                    }
                    R = run;
                }
                if (kt > 0) { ATT_WRITE(bo ^ ATT_BUF) if (kt > 1) ATT_LOAD(kt - 2) }
                LAS unsigned* vote = (LAS unsigned*)(L + 139296) + (bo ? 8 : 0);
                { const bool any = __ballot(R != 0.f) != 0ull; walive = any; if (lane == 0) vote[w] = any ? 1u : 0u; }
                __syncthreads();
                { const u32x4 v0 = *(const LAS u32x4*)(vote), v1 = *(const LAS u32x4*)(vote + 4);
                  if (((v0.x | v0.y) | (v0.z | v0.w) | (v1.x | v1.y) | (v1.z | v1.w)) == 0u) break; }
            }
#undef ATT_LOAD
#undef ATT_WRITE
            bf16_t* yrow = Y + (rowb + q0) * DM + hh * 128 + yoff;
#pragma unroll
            for (int g = 0; g < 4; ++g) {
                u32x2 v;
                v.x = pk2(O0[4 * g], O0[4 * g + 1]); v.y = pk2(O0[4 * g + 2], O0[4 * g + 3]); *(u32x2*)(yrow + 8 * g) = v;
                v.x = pk2(O1[4 * g], O1[4 * g + 1]); v.y = pk2(O1[4 * g + 2], O1[4 * g + 3]); *(u32x2*)(yrow + 32 + 8 * g) = v;
                v.x = pk2(O2[4 * g], O2[4 * g + 1]); v.y = pk2(O2[4 * g + 2], O2[4 * g + 3]); *(u32x2*)(yrow + 64 + 8 * g) = v;
                v.x = pk2(O3[4 * g], O3[4 * g + 1]); v.y = pk2(O3[4 * g + 2], O3[4 * g + 3]); *(u32x2*)(yrow + 96 + 8 * g) = v;
            }
        }
    }
}
DI void sg_stats(const bf16_t* Z, float* stats, int gw, int ngw, int lane) {
    for (int m = gw; m < T_TOK; m += ngw) {
        const u32x4* zr = (const u32x4*)(Z + (size_t)m * 4096 + 2048) + lane;
        float f[4][8]; float s = 0.f;
#pragma unroll
        for (int j = 0; j < 4; ++j) { unpack8(zr[64 * j], f[j]);
#pragma unroll
            for (int e = 0; e < 8; ++e) s += f[j][e]; }
        const float mean = wave_sum(s) * (1.f / 2048.f); float q = 0.f;
#pragma unroll
        for (int j = 0; j < 4; ++j)
#pragma unroll
            for (int e = 0; e < 8; ++e) { const float dd = f[j][e] - mean; q += dd * dd; }
        const float rstd = rsqrtf(wave_sum(q) * (1.f / 2048.f) + EPS);
        if (lane == 0) { stats[2 * m] = mean; stats[2 * m + 1] = rstd; }
    }
}
DI void sg_mix(const P& p, const bf16_t* Z, const float* stats, bf16_t* Y, LAS unsigned char* L) {
    const int tid = opaque_tid(), w = __builtin_amdgcn_readfirstlane(tid >> 6), lane = tid & 63, r = lane & 31, lh = lane >> 5;
    LAS unsigned char* Wp = L; LAS unsigned char* vT = L + 34816; LAS float* At = (LAS float*)(L + 34816 + 69632); LAS float* Bt = At + 128; LAS unsigned char* rawv = L + 105472;
    const int c = tid & 255, sg = tid >> 8;
    for (int u = blockIdx.x; u < 1024; u += gridDim.x) {
        const int g = u & 7, cn = u >> 3; const size_t base = (size_t)cn * 128;
        u32x4 vq[8];
        { const bf16_t* zp = Z + (base + (tid >> 5)) * 4096 + 2048 + g * 256 + (tid & 31) * 8;
#pragma unroll
          for (int j = 0; j < 8; ++j) vq[j] = *(const u32x4*)(zp + (size_t)(16 * j) * 4096); }
        f32x4 wv[8], st0[8], st1[8];
#pragma unroll
        for (int j = 0; j < 8; ++j) { const int idx = tid + 512 * j, t = idx >> 5, s4 = (idx & 31) * 4;
            wv[j] = *(const f32x4*)(p.sg_w_pos + ((size_t)g * 128 + t) * 128 + s4);
            st0[j] = *(const f32x4*)(stats + 2 * (base + s4)); st1[j] = *(const f32x4*)(stats + 2 * (base + s4) + 4); }
        __syncthreads();
#pragma unroll
        for (int j = 0; j < 8; ++j) { const int idx = tid + 512 * j, t = idx >> 5, s4 = (idx & 31) * 4;
            const float w0 = s4 <= t ? wv[j].x : 0.f, w1 = s4 + 1 <= t ? wv[j].y : 0.f, w2 = s4 + 2 <= t ? wv[j].z : 0.f, w3 = s4 + 3 <= t ? wv[j].w : 0.f;
            u32x2 o; o.x = pk2(w0 * st0[j].y, w1 * st0[j].w); o.y = pk2(w2 * st1[j].y, w3 * st1[j].w);
            *(LAS u32x2*)(Wp + t * 272 + s4 * 2) = o;
            float a = bflo(o.x) * st0[j].x + bfhi(o.x) * st0[j].z + bflo(o.y) * st1[j].x + bfhi(o.y) * st1[j].z;
            float bsum = (w0 + w1) + (w2 + w3);
#pragma unroll
            for (int o2 = 1; o2 < 32; o2 <<= 1) { a += __shfl_xor(a, o2); bsum += __shfl_xor(bsum, o2); }
            if ((lane & 31) == 0) { At[t] = a; Bt[t] = bsum; } }
#pragma unroll
        for (int hv = 0; hv < 2; ++hv) {
            if (hv) __syncthreads();
#pragma unroll
            for (int j = 0; j < 4; ++j) *(LAS u32x4*)(rawv + ((tid >> 5) + 16 * j) * 528 + (tid & 31) * 16) = vq[4 * hv + j];
            __syncthreads();
#pragma unroll
            for (int k = 0; k < 4; ++k) { unsigned e[8];
#pragma unroll
                for (int i = 0; i < 8; ++i) e[i] = *(const LAS bf16_t*)(rawv + (sg * 32 + 8 * k + i) * 528 + c * 2);
                u32x4 o; o.x = e[0] | (e[1] << 16); o.y = e[2] | (e[3] << 16); o.z = e[4] | (e[5] << 16); o.w = e[6] | (e[7] << 16);
                *(LAS u32x4*)(vT + c * 272 + (64 * hv + sg * 32 + 8 * k) * 2) = o; }
        }
        __syncthreads();
        bf16x8 af[8];
#pragma unroll
        for (int ks = 0; ks < 8; ++ks) af[ks] = *(const LAS bf16x8*)(vT + (32 * w + r) * 272 + (16 * ks + 8 * lh) * 2);
        const f32x4 gam[4] = { *(const f32x4*)(p.sg_v_gain + g * 256 + 32 * w + 4 * lh), *(const f32x4*)(p.sg_v_gain + g * 256 + 32 * w + 8 + 4 * lh),
                               *(const f32x4*)(p.sg_v_gain + g * 256 + 32 * w + 16 + 4 * lh), *(const f32x4*)(p.sg_v_gain + g * 256 + 32 * w + 24 + 4 * lh) };
        const f32x4 bet[4] = { *(const f32x4*)(p.sg_v_bias + g * 256 + 32 * w + 4 * lh), *(const f32x4*)(p.sg_v_bias + g * 256 + 32 * w + 8 + 4 * lh),
                               *(const f32x4*)(p.sg_v_bias + g * 256 + 32 * w + 16 + 4 * lh), *(const f32x4*)(p.sg_v_bias + g * 256 + 32 * w + 24 + 4 * lh) };
#pragma unroll
        for (int tt = 0; tt < 4; ++tt) {
            const int t = 32 * tt + r; const size_t row = base + t;
            u32x2 uu[4];
#pragma unroll
            for (int g4 = 0; g4 < 4; ++g4) uu[g4] = *(const u32x2*)(Z + row * 4096 + g * 256 + 32 * w + 8 * g4 + 4 * lh);
            const float bp = p.sg_b_pos[g * 128 + t], at = At[t], bt = Bt[t];
            f32x16 acc = zero16();
#pragma unroll
            for (int ks = 0; ks < 8; ++ks) if (ks <= 2 * tt + 1) { const bf16x8 bw = *(const LAS bf16x8*)(Wp + (32 * tt + r) * 272 + (16 * ks + 8 * lh) * 2); acc = MFMA32(af[ks], bw, acc); }
#pragma unroll
            for (int g4 = 0; g4 < 4; ++g4) {
                const float m0 = gam[g4].x * (acc[4 * g4] - at) + bet[g4].x * bt + bp, m1 = gam[g4].y * (acc[4 * g4 + 1] - at) + bet[g4].y * bt + bp;
                const float m2 = gam[g4].z * (acc[4 * g4 + 2] - at) + bet[g4].z * bt + bp, m3 = gam[g4].w * (acc[4 * g4 + 3] - at) + bet[g4].w * bt + bp;
                u32x2 o; o.x = pk2(bflo(uu[g4].x) * m0, bfhi(uu[g4].x) * m1); o.y = pk2(bflo(uu[g4].y) * m2, bfhi(uu[g4].y) * m3);
                *(u32x2*)(Y + row * DM + g * 256 + 32 * w + 8 * g4 + 4 * lh) = o; }
        }
    }
}
constexpr size_t WS_BAR = 9 * MiB;
constexpr size_t WS_QCNT = WS_BAR + 32768;
constexpr size_t WS_ROWSS = WS_BAR + 65536, WS_PCNT = WS_BAR + 524288, WS_ZERO_BYTES = 1048576;
constexpr int LDS_BARST = 139264;
#define XB_TMO      128
#define XB_XCNT(j)  (256  + 64 * (j))
#define XB_XSUB(j)  (1280 + 64 * (j))
#define XB_XGEN(j)  (2304 + 64 * (j))
#define XB_TOP      3328
#define XB_TOPGEN   3392
#define XCD_BAR_WORDS 3456
#define XB_SPIN_CAP (1u << 18)

__device__ __forceinline__ unsigned xb_ld(unsigned* p)              { return __hip_atomic_load(p, __ATOMIC_RELAXED, __HIP_MEMORY_SCOPE_AGENT); }
__device__ __forceinline__ unsigned xb_add(unsigned* p, unsigned v) { return __hip_atomic_fetch_add(p, v, __ATOMIC_RELAXED, __HIP_MEMORY_SCOPE_AGENT); }
__device__ __forceinline__ unsigned xb_xcc_id() { return (unsigned)__builtin_amdgcn_s_getreg((3 << 11) | 20) & 0xFu; }
#define XB_SPIN(cond, bar) do { unsigned _sp = 0; while (cond) { __builtin_amdgcn_s_sleep(1); \
    if ((++_sp & 255u) == 0u) { if (xb_ld(&(bar)[XB_TMO])) break; if (_sp > XB_SPIN_CAP) { atomicAdd(&(bar)[XB_TMO], 1u); break; } } } } while (0)

struct XcdBarrier {
    unsigned* bar; unsigned x;
    volatile LAS unsigned* st;
};

__device__ __forceinline__ XcdBarrier xcd_barrier_post(unsigned* bar, volatile LAS unsigned* st) {
    XcdBarrier b; b.bar = bar; b.x = xb_xcc_id(); b.st = st;
    if (threadIdx.x == 0) (void)xb_add(&bar[XB_XCNT(b.x)], 1u);
    return b;
}
__device__ __forceinline__ void xcd_barrier_complete(unsigned* bar, unsigned x, unsigned& nloc, unsigned& nx) {
    const unsigned G = gridDim.x * gridDim.y * gridDim.z;
    unsigned sum, cnt, mine, sp = 0u;
    for (;;) {
        sum = 0u; cnt = 0u; mine = 0u;
#pragma unroll
        for (unsigned j = 0; j < 16; ++j) { const unsigned c = xb_ld(&bar[XB_XCNT(j)]); sum += c; cnt += (c > 0u) ? 1u : 0u; mine = (j == x) ? c : mine; }
        if (sum == G) break;
        __builtin_amdgcn_s_sleep(1);
        if ((++sp & 255u) == 0u) { if (xb_ld(&bar[XB_TMO])) break; if (sp > XB_SPIN_CAP) { atomicAdd(&bar[XB_TMO], 1u); break; } }
    }
    nloc = mine > 0u ? mine : 1u; nx = cnt > 0u ? cnt : 1u;
}

__device__ __forceinline__ void xcd_barrier(const XcdBarrier& b) {
    asm volatile("s_waitcnt vmcnt(0)" ::: "memory");
    __syncthreads();
    if (threadIdx.x == 0) {
        unsigned* bar = b.bar;
        __builtin_amdgcn_s_waitcnt(0);
        unsigned nloc = b.st[0], nx = b.st[1];
        if (nloc == 0u) { xcd_barrier_complete(bar, b.x, nloc, nx); b.st[0] = nloc; b.st[1] = nx; }
        const unsigned old = xb_add(&bar[XB_XSUB(b.x)], 1u);
        const unsigned gen = old / nloc;
        if (old + 1u == (gen + 1u) * nloc) {
            __builtin_amdgcn_fence(__ATOMIC_RELEASE, "agent");
            asm volatile("s_waitcnt vmcnt(0)" ::: "memory");
            const unsigned og = xb_add(&bar[XB_TOP], 1u);
            const unsigned tg = og / nx;
            if (og + 1u == (tg + 1u) * nx) xb_add(&bar[XB_TOPGEN], 1u);
            else XB_SPIN(xb_ld(&bar[XB_TOPGEN]) == tg, bar);
            __builtin_amdgcn_fence(__ATOMIC_ACQUIRE, "agent");
            xb_add(&bar[XB_XGEN(b.x)], 1u);
            asm volatile("s_waitcnt vmcnt(0)" ::: "memory");
        } else {
            XB_SPIN(xb_ld(&bar[XB_XGEN(b.x)]) == gen, bar);
            __builtin_amdgcn_fence(__ATOMIC_ACQUIRE, "agent");
            asm volatile("s_waitcnt vmcnt(0)" ::: "memory");
        }
    }
    __syncthreads();
}


template <class Epi, class Sched = pg8::StaticOrder> DI void run_gemm(LAS unsigned char* lds, const bf16_t* A, const bf16_t* Bt, int N, int K, const Epi& E) {
    pg8::Gemm g{A, Bt, T_TOK, N, K}; Sched S; S.init(T_TOK, N, (int)gridDim.x, (int)blockIdx.x);
    pg8::gemm_phase<Epi, Sched, true, true>((PG8_LAS unsigned char*)lds, g, S, E);
}

#define PHASE_HEAD() const int tid = opaque_tid(), lane = tid & 63, wave = __builtin_amdgcn_readfirstlane(tid >> 6); const int gw = blockIdx.x * 8 + wave, ngw = gridDim.x * 8; (void)lane; (void)gw; (void)ngw;
#define WSP(T, off) ((T*)(p.ws + (off)))
typedef const __attribute__((address_space(4))) unsigned long long* KAP;
DI P load_args() {
    KAP kp = (KAP)__builtin_amdgcn_kernarg_segment_ptr();
    asm volatile("" : "+s"(kp));
    P p;
#define KARGF(i) ((const float*)(const __attribute__((address_space(1))) float*)kp[i])
    p.x = KARGF(0); p.c = KARGF(1); p.ada_w = KARGF(2); p.ada_b = KARGF(3); p.mix_norm = KARGF(4); p.ffn_norm = KARGF(5);
    p.par_w_in = KARGF(6); p.par_w_out = KARGF(7); p.lb_logits = KARGF(8); p.hg_out_norm = KARGF(9); p.sg_w_in = KARGF(10);
    p.sg_v_gain = KARGF(11); p.sg_v_bias = KARGF(12); p.sg_w_pos = KARGF(13); p.sg_b_pos = KARGF(14); p.sg_w_out = KARGF(15);
    p.ffn_up = KARGF(16); p.conv_w = KARGF(17); p.conv_b = KARGF(18); p.ffn_down = KARGF(19); p.final_norm = KARGF(20);
    p.out = (float*)(__attribute__((address_space(1))) float*)kp[21]; p.ws = (unsigned char*)(__attribute__((address_space(1))) unsigned char*)kp[22];
#undef KARGF
    return p;
}
#define LDSP ((LAS unsigned char*)lds_raw)
#ifndef REP_A
#define REP_A 1
#endif
#ifndef REP_B
#define REP_B 1
#endif
#ifndef REP_C
#define REP_C 1
#endif
#ifndef REP_S
#define REP_S 1
#endif
#define GSYNC() do { for (int rs_ = 0; rs_ < REP_S; ++rs_) { const P pb_ = load_args(); XcdBarrier xb_; xb_.bar = (unsigned*)(pb_.ws + WS_BAR); xb_.x = xb_xcc_id(); xb_.st = (volatile LAS unsigned*)(LDSP + LDS_BARST); xcd_barrier(xb_); } } while (0)
#define RA for (int ra_ = 0; ra_ < REP_A; ++ra_)
#define RB for (int rb_ = 0; rb_ < REP_B; ++rb_)
#define RC for (int rc_ = 0; rc_ < REP_C; ++rc_)

#define FUSED_NORM (gridDim.x == 256)
#define RNORM(id) WSP(float, WS_ROWSS) + (id) * 16384, WSP(unsigned, WS_PCNT) + (id) * 4096
template <int LAYER> DI void ffn_block(unsigned char* lds_raw, cg::grid_group& grid) {
    if (!FUSED_NORM) {
        RA { const P p = load_args(); PHASE_HEAD(); const float* modl = WSP(const float, WS_MOD) + (size_t)LAYER * 4 * MODW;
          norm_rows(p.out, p.ffn_norm + LAYER * DM, modl + 3 * DM, modl + 4 * DM, WSP(bf16_t, WS_HY), gw, ngw, lane); }
        GSYNC();
    }
    RC { const P p = load_args(); pg8::EpiConv E{WSP(bf16_t, WS_U), WSP(float, WS_UT), p.conv_w + (size_t)LAYER * 3 * FF2, p.conv_b + (size_t)LAYER * FF2, (PG8_LAS unsigned char*)(LDSP + 131072)};
         run_gemm(LDSP, WSP(const bf16_t, WS_HY), WSP(const bf16_t, WS_WU), FF2, DM, E); }
    GSYNC();
    { const P p = load_args(); conv_fixup(WSP(const float, WS_UT), p.conv_w + (size_t)LAYER * 3 * FF2, p.conv_b + (size_t)LAYER * FF2, WSP(bf16_t, WS_U)); }
    GSYNC();
    { const P p = load_args(); const float* modl = WSP(const float, WS_MOD) + (size_t)LAYER * 4 * MODW;
      if (FUSED_NORM) {
          const float* mod1 = WSP(const float, WS_MOD) + 4 * MODW;
          if (LAYER == 0) { pg8::EpiResidNorm<1, 1> E{WSP(bf16_t, WS_XB), WSP(bf16_t, WS_XB), modl + 5 * DM, p.mix_norm + DM, mod1 + DM, mod1, WSP(bf16_t, WS_HY), RNORM(1)}; run_gemm<pg8::EpiResidNorm<1, 1>, pg8::PanelOrder>(LDSP, WSP(const bf16_t, WS_U), WSP(const bf16_t, WS_WD), DM, FF, E); }
          else { pg8::EpiResidNorm<1, 2> E{WSP(bf16_t, WS_XB), p.out, modl + 5 * DM, p.final_norm, nullptr, nullptr, WSP(bf16_t, WS_HY), RNORM(3)}; run_gemm<pg8::EpiResidNorm<1, 2>, pg8::PanelOrder>(LDSP, WSP(const bf16_t, WS_U), WSP(const bf16_t, WS_WD), DM, FF, E); }
      } else { pg8::EpiResid E{p.out, p.out, modl + 5 * DM}; run_gemm(LDSP, WSP(const bf16_t, WS_U), WSP(const bf16_t, WS_WD), DM, FF, E); } }
    GSYNC();
}

__global__ void __launch_bounds__(512, 2) fwd_megakernel(P p_arg) {
    extern __shared__ __attribute__((aligned(16))) unsigned char lds_raw[];
    cg::grid_group grid = cg::this_grid();
    { if (threadIdx.x < 2) ((volatile LAS unsigned*)(LDSP + LDS_BARST))[threadIdx.x] = 0u;
      __syncthreads();
      const P pb_ = load_args(); if (pb_.ws == nullptr) grid.sync();
      (void)xcd_barrier_post((unsigned*)(pb_.ws + WS_BAR), (volatile LAS unsigned*)(LDSP + LDS_BARST)); }
    RA { const P p = load_args(); PHASE_HEAD(); convert_weights(p, 0, LDSP, gw, ngw, wave, lane); ada_partials(p, LDSP); }
    GSYNC();
    RA { const P p = load_args(); mod_reduce(p); }
    GSYNC();
    RA { const P p = load_args(); PHASE_HEAD(); const float* mod0 = WSP(const float, WS_MOD); norm_rows(p.x, p.mix_norm, mod0, mod0 + DM, WSP(bf16_t, WS_HY), gw, ngw, lane); }
    GSYNC();
    RC { const P p = load_args(); pg8::EpiBf16 E{WSP(bf16_t, WS_BIG), PIN, 0}; run_gemm(LDSP, WSP(const bf16_t, WS_HY), WSP(const bf16_t, WS_WA), PIN, DM, E); }
    GSYNC();
    RB { const P p = load_args(); v_transpose(WSP(const bf16_t, WS_BIG), WSP(bf16_t, WS_VT), LDSP); }
#ifdef REP_HGA
    for (int rq_ = 0; rq_ < 2; ++rq_)
#endif
    RB { const P p = load_args(); hg_phase_a(p, WSP(const bf16_t, WS_BIG), WSP(float, WS_UT), WSP(float, WS_DEC), LDSP); }
    GSYNC();
    RB { const P p = load_args(); hg_phase_b(WSP(const float, WS_UT), WSP(const float, WS_DEC), WSP(bf16_t, WS_ST)); }
    GSYNC();
#ifdef REP_ATT
    for (int rq_ = 0; rq_ < REP_ATT; ++rq_)
#endif
    RB { const P p = load_args(); attn_phase(WSP(const bf16_t, WS_BIG), WSP(const bf16_t, WS_VT), WSP(bf16_t, WS_HY), LDSP, WSP(unsigned, WS_QCNT)); }
#ifdef REP_HGC
    for (int rq_ = 0; rq_ < 2; ++rq_)
#endif
    RB { const P p = load_args(); hg_phase_c(p, WSP(const bf16_t, WS_BIG), WSP(const bf16_t, WS_ST), WSP(bf16_t, WS_HY), LDSP, WSP(unsigned, WS_QCNT) + 128); }
    GSYNC();
    { const P p = load_args(); const float* mod0 = WSP(const float, WS_MOD);
      if (FUSED_NORM) { pg8::EpiResidNorm<0, 1> E{p.x, WSP(bf16_t, WS_XB), mod0 + 2 * DM, p.ffn_norm, mod0 + 4 * DM, mod0 + 3 * DM, WSP(bf16_t, WS_HY), RNORM(0)}; run_gemm<pg8::EpiResidNorm<0, 1>, pg8::PanelOrder>(LDSP, WSP(const bf16_t, WS_HY), WSP(const bf16_t, WS_WO), DM, DM, E); }
      else { pg8::EpiResid E{p.x, p.out, mod0 + 2 * DM}; run_gemm(LDSP, WSP(const bf16_t, WS_HY), WSP(const bf16_t, WS_WO), DM, DM, E); } }
    GSYNC();
    ffn_block<0>(lds_raw, grid);
    RA { const P p = load_args(); PHASE_HEAD(); const float* mod1 = WSP(const float, WS_MOD) + 4 * MODW;
      if (!FUSED_NORM) norm_rows(p.out, p.mix_norm + DM, mod1, mod1 + DM, WSP(bf16_t, WS_HY), gw, ngw, lane);
      convert_weights(p, 1, LDSP, gw, ngw, wave, lane); }
    GSYNC();
    RC { const P p = load_args(); pg8::EpiBf16 E{WSP(bf16_t, WS_Z), 4096, 1}; run_gemm(LDSP, WSP(const bf16_t, WS_HY), WSP(const bf16_t, WS_WA), 4096, DM, E); }
    GSYNC();
    RB { const P p = load_args(); PHASE_HEAD(); sg_stats(WSP(const bf16_t, WS_Z), WSP(float, WS_STATS), gw, ngw, lane); }
    GSYNC();
#ifdef REP_SG
    for (int rq_ = 0; rq_ < 2; ++rq_)
#endif
    RB { const P p = load_args(); sg_mix(p, WSP(const bf16_t, WS_Z), WSP(const float, WS_STATS), WSP(bf16_t, WS_HY), LDSP); }
    GSYNC();
    { const P p = load_args(); const float* mod1 = WSP(const float, WS_MOD) + 4 * MODW;
      if (FUSED_NORM) { pg8::EpiResidNorm<1, 1> E{WSP(bf16_t, WS_XB), WSP(bf16_t, WS_XB), mod1 + 2 * DM, p.ffn_norm + DM, mod1 + 4 * DM, mod1 + 3 * DM, WSP(bf16_t, WS_HY), RNORM(2)}; run_gemm<pg8::EpiResidNorm<1, 1>, pg8::PanelOrder>(LDSP, WSP(const bf16_t, WS_HY), WSP(const bf16_t, WS_WO), DM, DM, E); }
      else { pg8::EpiResid E{p.out, p.out, mod1 + 2 * DM}; run_gemm(LDSP, WSP(const bf16_t, WS_HY), WSP(const bf16_t, WS_WO), DM, DM, E); } }
    GSYNC();
    ffn_block<1>(lds_raw, grid);
    if (!FUSED_NORM) { const P p = load_args(); PHASE_HEAD(); final_norm_rows(p.out, p.final_norm, gw, ngw, lane); }
}

extern "C" void kernel_launch(void* const* d_in, const int* in_sizes, int n_in, void* d_out, int out_size, void* d_ws, size_t ws_size, hipStream_t stream) {
    static int grid = 0;
    if (grid == 0) {
        if (n_in != 21 || out_size != T_TOK * DM || ws_size < WS_END) { fprintf(stderr, "kernel_launch: unexpected shapes: n_in %d out %d ws %zu (need %zu)\n", n_in, out_size, ws_size, (size_t)WS_END); grid = -1; return; }
        int dev = 0, cus = 0, per_cu = 0;
        hipGetDevice(&dev); hipDeviceGetAttribute(&cus, hipDeviceAttributeMultiprocessorCount, dev);
        if (hipFuncSetAttribute((const void*)fwd_megakernel, hipFuncAttributeMaxDynamicSharedMemorySize, LDS_BYTES) != hipSuccess) { fprintf(stderr, "kernel_launch: hipFuncSetAttribute failed\n"); grid = -1; return; }
        if (hipOccupancyMaxActiveBlocksPerMultiprocessor(&per_cu, (const void*)fwd_megakernel, 512, LDS_BYTES) != hipSuccess || per_cu < 1) { fprintf(stderr, "kernel_launch: occupancy query says %d\n", per_cu); per_cu = 1; }
        (void)hipGetLastError();
        grid = cus * 1;
    }
    if (grid < 0) return;
    if (hipMemsetAsync((char*)d_ws + WS_BAR, 0, WS_ZERO_BYTES, stream) != hipSuccess) { fprintf(stderr, "kernel_launch: memset failed\n"); return; }
    P p{};
    const float** f = (const float**)&p;
    for (int i = 0; i < 21; ++i) f[i] = (const float*)d_in[i];
    p.out = (float*)d_out; p.ws = (unsigned char*)d_ws;
    void* args[] = {&p};
    hipError_t e = hipLaunchCooperativeKernel((const void*)fwd_megakernel, dim3(grid), dim3(512), args, LDS_BYTES, stream);
    if (e != hipSuccess) fprintf(stderr, "cooperative launch failed: %s (grid %d)\n", hipGetErrorString(e), grid);
}
```

```cpp
#include <hip/hip_runtime.h>
#include <hip/hip_cooperative_groups.h>
#include <cstdio>
#include <cstdint>
namespace cg = cooperative_groups;
__device__ __forceinline__ int opaque_tid() { int t = threadIdx.x; asm volatile("" : "+v"(t)); return t; }
namespace pg8 {
#define PG8_LAS __attribute__((address_space(3)))
typedef unsigned short bf16_t;
typedef short bf16x8 __attribute__((ext_vector_type(8)));
typedef float f32x4 __attribute__((ext_vector_type(4)));
typedef unsigned u32x4 __attribute__((ext_vector_type(4)));
constexpr int BM = 256, BK = 64, HALF = 128, HTB = HALF * BK * 2  , STAGE_BYTES = 8 * HTB, NXCD = 8, WGM = 8;

__host__ __device__ __forceinline__ int lds_byte(int r, int c) { const int st = (r >> 4) * 2 + (c >> 5), rr = r & 15, cc = c & 31, ob = rr * 64 + cc * 2; return st * 1024 + (ob ^ (((ob >> 9) & 1) << 5)); }
__host__ __device__ __forceinline__ void stage_rc(int b, int& R, int& C) { const int st = b / 1024, sb = b % 1024, swz = sb ^ (((sb >> 9) & 1) << 5); R = (st >> 1) * 16 + swz / 64; C = (st & 1) * 32 + (swz % 64) / 2; }
__host__ __device__ __forceinline__ int perm32(int rho) { const int n = rho >> 4, i = rho & 15; return 8 * (i >> 2) + 4 * n + (i & 3); }

struct Unit { int pm, pn; };
struct Gemm { const bf16_t* A; const bf16_t* Bt; int M, N, K; };

struct StaticOrder {
    int nM, nN, nwg, G, c;
    __host__ __device__ void init(int M, int N, int G_, int c_) { nM = M / BM; nN = N / BM; nwg = nM * nN; G = G_; c = c_; }
    __host__ __device__ bool next(int i, Unit& u) const {
        const long L = (long)i * G + c; if (L >= nwg) return false;
        int wgid = (int)L; { const int q = nwg / NXCD, r = nwg % NXCD, xcd = wgid % NXCD, off = wgid / NXCD; wgid = (xcd < r ? xcd * (q + 1) : r * (q + 1) + (xcd - r) * q) + off; }
        const int nig = WGM * nN, gid = wgid / nig, fm = gid * WGM, gsz = (nM - fm) < WGM ? (nM - fm) : WGM;
        u.pm = fm + ((wgid % nig) % gsz); u.pn = (wgid % nig) / gsz; return true;
    }
    __device__ __forceinline__ void a_ready(const Unit&) const {}
    __device__ __forceinline__ void done(const Unit&) const {}
};
struct PanelOrder {
    int c, nr;
    __host__ __device__ void init(int M, int, int, int c_) { c = c_; nr = M / (32 * BM); }
    __host__ __device__ bool next(int i, Unit& u) const { if (i >= nr) return false; const int xcd = c & 7, idx = c >> 3; u.pm = 32 * i + 4 * xcd + (idx >> 3); u.pn = idx & 7; return true; }
    __device__ __forceinline__ void a_ready(const Unit&) const {}
    __device__ __forceinline__ void done(const Unit&) const {}
};

typedef float f32x2 __attribute__((ext_vector_type(2)));
typedef __bf16 bf16v2 __attribute__((ext_vector_type(2)));
__device__ __forceinline__ unsigned cvt_pk_bf16(float lo, float hi) { f32x2 v = {lo, hi}; return __builtin_bit_cast(unsigned, __builtin_convertvector(v, bf16v2)); }
__device__ __forceinline__ f32x2 gelu_pk(f32x2 v) {
    const f32x2 av = __builtin_elementwise_abs(v), d = av * 0.2316418882f + 1.0f;
    f32x2 t; t.x = __builtin_amdgcn_rcpf(d.x); t.y = __builtin_amdgcn_rcpf(d.y);
    f32x2 q = t * 0.5307027145f + (-0.7265760135f); q = q * t + 0.7107068705f; q = q * t + (-0.142248368f); q = q * t + 0.127414796f; q = q * t;
    const f32x2 s = (v * v) * (-0.72134752044f);
    f32x2 e; e.x = __builtin_amdgcn_exp2f(s.x); e.y = __builtin_amdgcn_exp2f(s.y);
    const f32x2 m = v * (q * e), r = v - m;
    f32x2 o; o.x = v.x < 0.f ? m.x : r.x; o.y = v.y < 0.f ? m.y : r.y; return o;
}
struct EpiBf16 {
    static constexpr bool PERM = true, AFTER_DRAIN = false;
    bf16_t* O; int ldc; int act;
    __device__ __forceinline__ void operator()(const f32x4 (&acc)[2][2][4][2], const Unit& u, int wr, int wc, int fr, int fq) const {
        const int row0 = u.pm * BM + wr * 64 + fr; const int col0 = u.pn * BM + wc * 32 + 8 * fq;
#pragma unroll
        for (int ai = 0; ai < 2; ++ai)
#pragma unroll
            for (int m = 0; m < 4; ++m) { bf16_t* rowp = O + (size_t)(row0 + ai * HALF + m * 16) * ldc + col0;
#pragma unroll
                for (int bj = 0; bj < 2; ++bj) { f32x4 v0 = acc[ai][bj][m][0], v1 = acc[ai][bj][m][1];
                    if (act) { f32x2 a = gelu_pk((f32x2){v0[0], v0[1]}), b = gelu_pk((f32x2){v0[2], v0[3]}), c = gelu_pk((f32x2){v1[0], v1[1]}), d = gelu_pk((f32x2){v1[2], v1[3]});
                        v0 = (f32x4){a.x, a.y, b.x, b.y}; v1 = (f32x4){c.x, c.y, d.x, d.y}; }
                    u32x4 w; w.x = cvt_pk_bf16(v0[0], v0[1]); w.y = cvt_pk_bf16(v0[2], v0[3]); w.z = cvt_pk_bf16(v1[0], v1[1]); w.w = cvt_pk_bf16(v1[2], v1[3]);
                    *(u32x4*)(rowp + bj * HALF) = w; } }
    }
};
struct EpiResid {
    static constexpr bool PERM = false, AFTER_DRAIN = false;
    const float* Xin; float* Xout; const float* gate;
    __device__ __forceinline__ void operator()(const f32x4 (&acc)[2][2][4][2], const Unit& u, int wr, int wc, int fr, int fq) const {
        const int row0 = u.pm * BM + wr * 64 + fr, col0 = u.pn * BM + wc * 32 + 4 * fq; const int b = u.pm >> 4;
        f32x4 gv[2][2];
#pragma unroll
        for (int bj = 0; bj < 2; ++bj)
#pragma unroll
            for (int n = 0; n < 2; ++n) gv[bj][n] = *(const f32x4*)(gate + (size_t)b * 12288 + col0 + bj * HALF + n * 16);
        f32x4 xa[2][2], xb[2][2];
#define RES_LD(dst, g) { const size_t off_ = (size_t)(row0 + ((g) >> 2) * HALF + ((g) & 3) * 16) * 2048 + col0; \
            dst[0][0] = *(const f32x4*)(Xin + off_); dst[0][1] = *(const f32x4*)(Xin + off_ + 16); dst[1][0] = *(const f32x4*)(Xin + off_ + HALF); dst[1][1] = *(const f32x4*)(Xin + off_ + HALF + 16); }
#define RES_ST(src, g) { const size_t off_ = (size_t)(row0 + ((g) >> 2) * HALF + ((g) & 3) * 16) * 2048 + col0; \
            *(f32x4*)(Xout + off_) = src[0][0] + gv[0][0] * acc[(g) >> 2][0][(g) & 3][0]; *(f32x4*)(Xout + off_ + 16) = src[0][1] + gv[0][1] * acc[(g) >> 2][0][(g) & 3][1]; \
            *(f32x4*)(Xout + off_ + HALF) = src[1][0] + gv[1][0] * acc[(g) >> 2][1][(g) & 3][0]; *(f32x4*)(Xout + off_ + HALF + 16) = src[1][1] + gv[1][1] * acc[(g) >> 2][1][(g) & 3][1]; }
        RES_LD(xa, 0)
#pragma unroll
        for (int g = 0; g < 8; g += 2) {
            RES_LD(xb, g + 1)
            asm volatile("" ::: "memory");
            RES_ST(xa, g)
            asm volatile("" ::: "memory");
            if (g + 2 < 8) RES_LD(xa, g + 2)
            asm volatile("" ::: "memory");
            RES_ST(xb, g + 1)
            asm volatile("" ::: "memory");
        }
#undef RES_LD
#undef RES_ST
    }
};

typedef unsigned u32x2 __attribute__((ext_vector_type(2)));
template <int XIN, int XST> struct EpiResidNorm {
    static constexpr bool PERM = false, AFTER_DRAIN = false;
    const void* Xin; void* Xout; const float* gate; const float* gain; const float* sc; const float* sh; bf16_t* H; float* rowss; unsigned* cnt;
    __device__ __forceinline__ void operator()(f32x4 (&acc)[2][2][4][2], const Unit& u, int wr, int wc, int fr, int fq) const {
        const int row0 = u.pm * BM + wr * 64 + fr, col0 = u.pn * BM + wc * 32 + 4 * fq; const int b = u.pm >> 4;
        const bool fin = (sc == nullptr);
        f32x4 gv[2][2];
#pragma unroll
        for (int bj = 0; bj < 2; ++bj)
#pragma unroll
            for (int n = 0; n < 2; ++n) gv[bj][n] = *(const f32x4*)(gate + (size_t)b * 12288 + col0 + bj * HALF + n * 16);
        f32x4 xa[2][2], xb[2][2];
#define RES_LD1(dst, o2) { if (XIN == 0) dst = *(const f32x4*)((const float*)Xin + (o2)); else { const u32x2 w_ = *(const u32x2*)((const bf16_t*)Xin + (o2)); \
                dst = (f32x4){__uint_as_float(w_.x << 16), __uint_as_float(w_.x & 0xffff0000u), __uint_as_float(w_.y << 16), __uint_as_float(w_.y & 0xffff0000u)}; } }
#define RES_LD(dst, g) { const size_t off_ = (size_t)(row0 + ((g) >> 2) * HALF + ((g) & 3) * 16) * 2048 + col0; \
            RES_LD1(dst[0][0], off_) RES_LD1(dst[0][1], off_ + 16) RES_LD1(dst[1][0], off_ + HALF) RES_LD1(dst[1][1], off_ + HALF + 16) }
#define RES_ST(src, g) { const size_t off_ = (size_t)(row0 + ((g) >> 2) * HALF + ((g) & 3) * 16) * 2048 + col0; float ss_ = 0.f; \
            _Pragma("unroll") for (int bj_ = 0; bj_ < 2; ++bj_) _Pragma("unroll") for (int n_ = 0; n_ < 2; ++n_) { \
                const f32x4 x_ = src[bj_][n_] + gv[bj_][n_] * acc[(g) >> 2][bj_][(g) & 3][n_]; acc[(g) >> 2][bj_][(g) & 3][n_] = x_; \
                ss_ += (x_[0] * x_[0] + x_[1] * x_[1]) + (x_[2] * x_[2] + x_[3] * x_[3]); \
                if (XST == 0) *(f32x4*)((float*)Xout + off_ + bj_ * HALF + n_ * 16) = x_; \
                if (XST == 1) { u32x2 w_; w_.x = cvt_pk_bf16(x_[0], x_[1]); w_.y = cvt_pk_bf16(x_[2], x_[3]); *(u32x2*)((bf16_t*)Xout + off_ + bj_ * HALF + n_ * 16) = w_; } } \
            ss_ += __shfl_xor(ss_, 16); ss_ += __shfl_xor(ss_, 32); \
            if (fq == 0) (void)__hip_atomic_fetch_add(rowss + row0 + ((g) >> 2) * HALF + ((g) & 3) * 16, ss_, __ATOMIC_RELAXED, __HIP_MEMORY_SCOPE_AGENT); }
        RES_LD(xa, 0)
#pragma unroll
        for (int g = 0; g < 8; g += 2) {
            RES_LD(xb, g + 1)
            asm volatile("" ::: "memory");
            RES_ST(xa, g)
            asm volatile("" ::: "memory");
            if (g + 2 < 8) RES_LD(xa, g + 2)
            asm volatile("" ::: "memory");
            RES_ST(xb, g + 1)
            asm volatile("" ::: "memory");
        }
#undef RES_LD
#undef RES_LD1
#undef RES_ST
        asm volatile("s_waitcnt vmcnt(0)" ::: "memory");
        unsigned* c = cnt + 64 * u.pm;
        if (fq * 16 + fr == 0) (void)__hip_atomic_fetch_add(c, 1u, __ATOMIC_RELAXED, __HIP_MEMORY_SCOPE_AGENT);
        { unsigned sp = 0;
          while ((unsigned)__builtin_amdgcn_readfirstlane((int)__hip_atomic_load(c, __ATOMIC_RELAXED, __HIP_MEMORY_SCOPE_AGENT)) < 64u) { __builtin_amdgcn_s_sleep(1); if (++sp > (1u << 22)) break; } }
        f32x4 gg[2][2], hh[2][2];
#pragma unroll
        for (int bj = 0; bj < 2; ++bj)
#pragma unroll
            for (int n = 0; n < 2; ++n) { const int cc = col0 + bj * HALF + n * 16; const f32x4 ga = *(const f32x4*)(gain + cc);
                if (fin) { gg[bj][n] = ga; hh[bj][n] = (f32x4){0.f, 0.f, 0.f, 0.f}; }
                else { gg[bj][n] = ga * (*(const f32x4*)(sc + (size_t)b * 12288 + cc) + 1.0f); hh[bj][n] = *(const f32x4*)(sh + (size_t)b * 12288 + cc); } }
        float rsv[8];
        { const float* rp = rowss + row0;
          asm volatile("global_load_dword %0, %8, off sc1\n\tglobal_load_dword %1, %8, off offset:64 sc1\n\tglobal_load_dword %2, %8, off offset:128 sc1\n\tglobal_load_dword %3, %8, off offset:192 sc1\n\t"
                       "global_load_dword %4, %8, off offset:512 sc1\n\tglobal_load_dword %5, %8, off offset:576 sc1\n\tglobal_load_dword %6, %8, off offset:640 sc1\n\tglobal_load_dword %7, %8, off offset:704 sc1\n\t"
                       "s_waitcnt vmcnt(0)"
                       : "=&v"(rsv[0]), "=&v"(rsv[1]), "=&v"(rsv[2]), "=&v"(rsv[3]), "=&v"(rsv[4]), "=&v"(rsv[5]), "=&v"(rsv[6]), "=&v"(rsv[7]) : "v"(rp) : "memory"); }
#pragma unroll
        for (int g = 0; g < 8; ++g) {
            const int row = row0 + (g >> 2) * HALF + (g & 3) * 16;
            const float rstd = __builtin_amdgcn_rsqf(rsv[g] * (1.0f / 2048.0f) + 1e-6f);
#pragma unroll
            for (int bj = 0; bj < 2; ++bj)
#pragma unroll
                for (int n = 0; n < 2; ++n) { const f32x4 o = acc[g >> 2][bj][g & 3][n] * rstd * gg[bj][n] + hh[bj][n]; const size_t off = (size_t)row * 2048 + col0 + bj * HALF + n * 16;
                    if (fin) *(f32x4*)((float*)Xout + off) = o;
                    else { u32x2 w; w.x = cvt_pk_bf16(o[0], o[1]); w.y = cvt_pk_bf16(o[2], o[3]); *(u32x2*)(H + off) = w; } }
        }
    }
};

__device__ __forceinline__ float dpp_ror1(float v) { const int x = __builtin_bit_cast(int, v); return __builtin_bit_cast(float, __builtin_amdgcn_update_dpp(x, x, 0x121, 0xf, 0xf, false)); }
__device__ __forceinline__ float dpp_ror2(float v) { const int x = __builtin_bit_cast(int, v); return __builtin_bit_cast(float, __builtin_amdgcn_update_dpp(x, x, 0x122, 0xf, 0xf, false)); }
__device__ __forceinline__ float dpp_shr1(float old, float v) { return __builtin_bit_cast(float, __builtin_amdgcn_update_dpp(__builtin_bit_cast(int, old), __builtin_bit_cast(int, v), 0x111, 0xf, 0xf, false)); }
__device__ __forceinline__ float dpp_shr2(float old, float v) { return __builtin_bit_cast(float, __builtin_amdgcn_update_dpp(__builtin_bit_cast(int, old), __builtin_bit_cast(int, v), 0x112, 0xf, 0xf, false)); }
struct EpiConv {
    static constexpr bool PERM = false, AFTER_DRAIN = false;
    bf16_t* U; float* SB; const float* cw; const float* cb; PG8_LAS unsigned char* xb;
    __device__ __forceinline__ void operator()(const f32x4 (&acc)[2][2][4][2], const Unit& u, int wr, int wc, int fr, int fq) const {
        constexpr int FFc = 5632, FF2c = 11264;
        const int lane = fq * 16 + fr, l16 = fq * 16;
        const int row0 = u.pm * BM + wr * 64 + fr, jcol = u.pn * HALF + wc * 32 + 4 * fq;
        const f32x4 pwg0 = *(const f32x4*)(cw + jcol), pwg1 = *(const f32x4*)(cw + FF2c + jcol), pwg2 = *(const f32x4*)(cw + 2 * FF2c + jcol), pbg = *(const f32x4*)(cb + jcol);
        const f32x4 pwv0 = *(const f32x4*)(cw + FFc + jcol), pwv1 = *(const f32x4*)(cw + FF2c + FFc + jcol), pwv2 = *(const f32x4*)(cw + 2 * FF2c + FFc + jcol), pbv = *(const f32x4*)(cb + FFc + jcol);
#pragma unroll
        for (int ai = 0; ai < 2; ++ai) {
            if (fr >= 14) {
                PG8_LAS f32x4* dst = (PG8_LAS f32x4*)(xb + (((((ai * 2 + wr) * 4 + wc) * 2 + (fr - 14)) * 4 + fq) * 64));
                dst[0] = acc[ai][0][3][0]; dst[1] = acc[ai][0][3][1]; dst[2] = acc[ai][1][3][0]; dst[3] = acc[ai][1][3][1];
            }
        }
        { const int colb = u.pn * BM + wc * 32 + 4 * fq;
          if (wr == 0 && fr < 2) { float* sb = SB + ((size_t)(u.pm * 4 + fr)) * FF2c + colb;
              *(f32x4*)(sb) = acc[0][0][0][0]; *(f32x4*)(sb + 16) = acc[0][0][0][1]; *(f32x4*)(sb + HALF) = acc[0][1][0][0]; *(f32x4*)(sb + HALF + 16) = acc[0][1][0][1]; }
          if (wr == 1 && fr >= 14) { float* sb = SB + ((size_t)(u.pm * 4 + 2 + (fr - 14))) * FF2c + colb;
              *(f32x4*)(sb) = acc[1][0][3][0]; *(f32x4*)(sb + 16) = acc[1][0][3][1]; *(f32x4*)(sb + HALF) = acc[1][1][3][0]; *(f32x4*)(sb + HALF + 16) = acc[1][1][3][1]; } }
        asm volatile("s_waitcnt lgkmcnt(0)" ::: "memory"); __builtin_amdgcn_s_barrier(); asm volatile("" ::: "memory");
#pragma unroll
        for (int n = 0; n < 2; ++n) {
            const int j = jcol + 16 * n;
            f32x4 wg0, wg1, wg2, bg, wv0, wv1, wv2, bv;
            if (n == 0) { wg0 = pwg0; wg1 = pwg1; wg2 = pwg2; bg = pbg; wv0 = pwv0; wv1 = pwv1; wv2 = pwv2; bv = pbv; }
            else { wg0 = *(const f32x4*)(cw + j); wg1 = *(const f32x4*)(cw + FF2c + j); wg2 = *(const f32x4*)(cw + 2 * FF2c + j); bg = *(const f32x4*)(cb + j);
                   wv0 = *(const f32x4*)(cw + FFc + j); wv1 = *(const f32x4*)(cw + FF2c + FFc + j); wv2 = *(const f32x4*)(cw + 2 * FF2c + FFc + j); bv = *(const f32x4*)(cb + FFc + j); }
#pragma unroll
            for (int ai = 0; ai < 2; ++ai) {
                const int sa = (wr == 1) ? ai : 0, sw = (wr == 1) ? 0 : 1;
                const PG8_LAS f32x4* x63 = (const PG8_LAS f32x4*)(xb + (((((sa * 2 + sw) * 4 + wc) * 2 + 1) * 4 + fq) * 64));
                const PG8_LAS f32x4* x62 = (const PG8_LAS f32x4*)(xb + (((((sa * 2 + sw) * 4 + wc) * 2 + 0) * 4 + fq) * 64));
                const f32x4 g63 = x63[n], v63 = x63[2 + n], g62 = x62[n], v62 = x62[2 + n];
#pragma unroll
                for (int m = 0; m < 4; ++m) {
                    const f32x4 cg = acc[ai][0][m][n], cv = acc[ai][1][m][n];
                    f32x4 qg1, qg2, qv1, qv2;
                    if (m == 0) { qg1 = g63; qv1 = v63; qg2 = (fr == 0) ? g62 : g63; qv2 = (fr == 0) ? v62 : v63; }
                    else {
                        const f32x4 og = acc[ai][0][m > 0 ? m - 1 : 0][n], ov = acc[ai][1][m > 0 ? m - 1 : 0][n];
#pragma unroll
                        for (int e = 0; e < 4; ++e) { qg1[e] = dpp_ror1(og[e]); qg2[e] = dpp_ror2(og[e]); qv1[e] = dpp_ror1(ov[e]); qv2[e] = dpp_ror2(ov[e]); }
                    }
                    u32x2 o;
                    float r[4];
#pragma unroll
                    for (int e = 0; e < 4; ++e) {
                        const float g1 = dpp_shr1(qg1[e], cg[e]), g2 = dpp_shr2(qg2[e], cg[e]), v1 = dpp_shr1(qv1[e], cv[e]), v2 = dpp_shr2(qv2[e], cv[e]);
                        const float ag = bg[e] + wg0[e] * g2 + wg1[e] * g1 + wg2[e] * cg[e];
                        const float av = bv[e] + wv0[e] * v2 + wv1[e] * v1 + wv2[e] * cv[e];
                        r[e] = ag * __builtin_amdgcn_rcpf(1.f + __expf(-ag)) * av;
                    }
                    o.x = cvt_pk_bf16(r[0], r[1]); o.y = cvt_pk_bf16(r[2], r[3]);
                    const bool first2 = (ai == 0 && m == 0) && (wr == 0) && (fr < 2);
                    if (!first2) *(u32x2*)(U + (size_t)(row0 + ai * HALF + m * 16) * FFc + j) = o;
                }
            }
        }
    }
};

template <class Epi, class Sched, bool ALIGN_EPI = false, bool SP2 = false>
__device__ __forceinline__ void gemm_phase(PG8_LAS unsigned char* lds, const Gemm g, const Sched& S, const Epi& E) {
    const int tid = opaque_tid(), wid = __builtin_amdgcn_readfirstlane(tid >> 6), lane = tid & 63, wr = wid >> 2, wc = wid & 3, fr = lane & 15, fq = lane >> 4;
    const int K = g.K, nt = K / BK;
    unsigned voffA[2], voffB[2];
#pragma unroll
    for (int i = 0; i < 2; ++i) { int R, C; stage_rc(tid * 16 + i * 8192, R, C); const int Rb = Epi::PERM ? ((R & ~31) + perm32(R & 31)) : R;
        voffA[i] = (unsigned)(R * K + C) * 2u; voffB[i] = (unsigned)(Rb * K + C) * 2u; }
    const size_t kstep = (size_t)(BK * 2);
    const size_t hstep = (size_t)HALF * K * 2;
    const size_t tstep = 2 * hstep;
    const unsigned ldsw = (unsigned)wid * 1024u;
    const int aoff = lds_byte(wr * 64 + fr, fq * 8), boff = lds_byte(wc * 32 + fr, fq * 8);
#define PG8_SA(b, h) (((b) * 2 + (h)) * HTB)
#define PG8_SB(b, h) ((4 + (b) * 2 + (h)) * HTB)
#define PG8_STAGE(bufoff, gbase, voff) do { _Pragma("unroll") for (int _i = 0; _i < 2; ++_i) \
        __builtin_amdgcn_global_load_lds((const unsigned*)((const char*)(gbase) + (voff)[_i]), (PG8_LAS unsigned*)(lds + (bufoff) + ldsw + _i * 8192), 16, 0, 0); } while (0)
#define PG8_LDA(dst, b, h) do { _Pragma("unroll") for (int m = 0; m < 4; ++m) _Pragma("unroll") for (int k = 0; k < 2; ++k) dst[m][k] = *(const PG8_LAS bf16x8*)(lds + PG8_SA(b, h) + aoff + m * 2048 + k * 1024); } while (0)
#define PG8_LDB(dst, b, h) do { _Pragma("unroll") for (int n = 0; n < 2; ++n) _Pragma("unroll") for (int k = 0; k < 2; ++k) dst[n][k] = *(const PG8_LAS bf16x8*)(lds + PG8_SB(b, h) + boff + n * 2048 + k * 1024); } while (0)
#define PG8_MMA(ai, bj, At, Bt) do { __builtin_amdgcn_s_setprio(1); _Pragma("unroll") for (int m = 0; m < 4; ++m) _Pragma("unroll") for (int n = 0; n < 2; ++n) _Pragma("unroll") for (int k = 0; k < 2; ++k) \
        acc[ai][bj][m][n] = __builtin_amdgcn_mfma_f32_16x16x32_bf16(Bt[n][k], At[m][k], acc[ai][bj][m][n], 0, 0, 0); __builtin_amdgcn_s_setprio(0); } while (0)
#define PG8_WAIT_V(n) asm volatile("s_waitcnt vmcnt(" #n ")" ::: "memory")
#define PG8_WAIT_L(n) asm volatile("s_waitcnt lgkmcnt(" #n ")" ::: "memory")
#define PG8_BAR __builtin_amdgcn_s_barrier()
#define PG8_SCHED __builtin_amdgcn_sched_barrier(0)
    Unit cur, nxt; int ui = 0;
    if (!S.next(0, cur)) return;
    f32x4 acc[2][2][4][2];
#pragma unroll
    for (int a = 0; a < 2; ++a)
#pragma unroll
        for (int b = 0; b < 2; ++b)
#pragma unroll
            for (int m = 0; m < 4; ++m)
#pragma unroll
                for (int n = 0; n < 2; ++n) acc[a][b][m][n] = (f32x4){0.f, 0.f, 0.f, 0.f};
    bf16x8 At[4][2], B0[2][2], B1[2][2];
    const char* cA = (const char*)g.A + (size_t)cur.pm * tstep; const char* cB = (const char*)g.Bt + (size_t)cur.pn * tstep;
    S.a_ready(cur);
    if constexpr (SP2) {
        PG8_STAGE(PG8_SB(0, 0), cB, voffB); PG8_STAGE(PG8_SB(0, 1), cB + hstep, voffB); PG8_STAGE(PG8_SA(0, 0), cA, voffA); PG8_STAGE(PG8_SA(0, 1), cA + hstep, voffA);
        if (wr == 1) PG8_BAR;
        PG8_WAIT_V(2); PG8_BAR;
        PG8_STAGE(PG8_SB(1, 0), cB + kstep, voffB); PG8_STAGE(PG8_SA(1, 0), cA + kstep, voffA); PG8_STAGE(PG8_SB(1, 1), cB + hstep + kstep, voffB);
        PG8_WAIT_V(6); PG8_BAR;
    } else {
        PG8_STAGE(PG8_SB(0, 0), cB, voffB); PG8_STAGE(PG8_SA(0, 0), cA, voffA); PG8_STAGE(PG8_SB(0, 1), cB + hstep, voffB); PG8_STAGE(PG8_SA(0, 1), cA + hstep, voffA);
        if (wr == 1) PG8_BAR;
        PG8_WAIT_V(4); PG8_BAR;
        PG8_STAGE(PG8_SB(1, 0), cB + kstep, voffB); PG8_STAGE(PG8_SA(1, 0), cA + kstep, voffA); PG8_STAGE(PG8_SB(1, 1), cB + hstep + kstep, voffB);
        PG8_WAIT_V(6); PG8_BAR;
    }
    for (;;) {
        const bool has_next = S.next(ui + 1, nxt);
        const char* nA = has_next ? (const char*)g.A + (size_t)nxt.pm * tstep : cA; const char* nB = has_next ? (const char*)g.Bt + (size_t)nxt.pn * tstep : cB;
        for (int t = 0; t < nt; t += 2) {
            const bool last = (t == nt - 2);
            const char* a1 = cA + (size_t)(t + 1) * kstep;
            const char* a2 = last ? nA : cA + (size_t)(t + 2) * kstep; const char* b2 = last ? nB : cB + (size_t)(t + 2) * kstep;
            const char* a3 = a2 + kstep; const char* b3 = b2 + kstep;
            if (last && has_next) S.a_ready(nxt);
            if constexpr (SP2) {
            PG8_LDB(B0, 0, 0); PG8_LDB(B1, 0, 1); PG8_SCHED; PG8_LDA(At, 0, 0); PG8_STAGE(PG8_SA(1, 1), a1 + hstep, voffA);
            PG8_WAIT_V(8); PG8_WAIT_L(0); PG8_BAR; PG8_MMA(0, 0, At, B0); PG8_MMA(0, 1, At, B1); PG8_BAR; PG8_SCHED;
            PG8_LDA(At, 0, 1); PG8_STAGE(PG8_SB(0, 0), b2, voffB); PG8_STAGE(PG8_SB(0, 1), b2 + hstep, voffB); PG8_STAGE(PG8_SA(0, 0), a2, voffA);
            PG8_WAIT_V(8); PG8_WAIT_L(0); PG8_BAR; PG8_MMA(1, 0, At, B0); PG8_MMA(1, 1, At, B1); PG8_BAR; PG8_SCHED;
            PG8_LDB(B0, 1, 0); PG8_LDB(B1, 1, 1); PG8_SCHED; PG8_LDA(At, 1, 0); PG8_STAGE(PG8_SA(0, 1), a2 + hstep, voffA);
            PG8_WAIT_V(8); PG8_WAIT_L(0); PG8_BAR; PG8_MMA(0, 0, At, B0); PG8_MMA(0, 1, At, B1); PG8_BAR; PG8_SCHED;
            PG8_LDA(At, 1, 1); PG8_STAGE(PG8_SB(1, 0), b3, voffB); PG8_STAGE(PG8_SB(1, 1), b3 + hstep, voffB); PG8_STAGE(PG8_SA(1, 0), a3, voffA);
            PG8_WAIT_V(8); PG8_WAIT_L(0); PG8_BAR; PG8_MMA(1, 0, At, B0); PG8_MMA(1, 1, At, B1); PG8_BAR; PG8_SCHED;
            } else {
            PG8_LDB(B0, 0, 0); PG8_SCHED; PG8_LDA(At, 0, 0); PG8_STAGE(PG8_SA(1, 1), a1 + hstep, voffA);
            PG8_WAIT_L(8); PG8_BAR; PG8_WAIT_L(0); PG8_MMA(0, 0, At, B0); PG8_BAR; PG8_SCHED;
            PG8_LDB(B1, 0, 1); PG8_STAGE(PG8_SB(0, 0), b2, voffB);
            PG8_BAR; PG8_WAIT_L(0); PG8_MMA(0, 1, At, B1); PG8_BAR;
            PG8_LDA(At, 0, 1); PG8_STAGE(PG8_SA(0, 0), a2, voffA);
            PG8_BAR; PG8_WAIT_L(0); PG8_MMA(1, 0, At, B0); PG8_BAR; PG8_SCHED;
            PG8_STAGE(PG8_SB(0, 1), b2 + hstep, voffB);
            PG8_WAIT_V(6); PG8_BAR; PG8_MMA(1, 1, At, B1); PG8_BAR;
            PG8_LDB(B0, 1, 0); PG8_SCHED; PG8_LDA(At, 1, 0); PG8_STAGE(PG8_SA(0, 1), a2 + hstep, voffA);
            PG8_WAIT_L(8); PG8_BAR; PG8_WAIT_L(0); PG8_MMA(0, 0, At, B0); PG8_BAR; PG8_SCHED;
            PG8_LDB(B1, 1, 1); PG8_STAGE(PG8_SB(1, 0), b3, voffB);
            PG8_BAR; PG8_WAIT_L(0); PG8_MMA(0, 1, At, B1); PG8_BAR;
            PG8_LDA(At, 1, 1); PG8_STAGE(PG8_SA(1, 0), a3, voffA);
            PG8_BAR; PG8_WAIT_L(0); PG8_MMA(1, 0, At, B0); PG8_BAR; PG8_SCHED;
            PG8_STAGE(PG8_SB(1, 1), b3 + hstep, voffB);
            PG8_WAIT_V(6); PG8_BAR; PG8_MMA(1, 1, At, B1); PG8_BAR;
            }
        }
        if constexpr (ALIGN_EPI) { if (wr == 0) PG8_BAR; }
#ifdef REP_E
        if constexpr (Epi::PERM) { E(acc, cur, wr, wc, fr, fq); asm volatile("" ::: "memory"); }
#endif
        if constexpr (!Epi::AFTER_DRAIN) { E(acc, cur, wr, wc, fr, fq); S.done(cur); }
        if (!has_next) break;
#pragma unroll
        for (int a = 0; a < 2; ++a)
#pragma unroll
            for (int b = 0; b < 2; ++b)
#pragma unroll
                for (int m = 0; m < 4; ++m)
#pragma unroll
                    for (int n = 0; n < 2; ++n) acc[a][b][m][n] = (f32x4){0.f, 0.f, 0.f, 0.f};
        cur = nxt; cA = nA; cB = nB; ++ui;
        if constexpr (ALIGN_EPI) { if (wr == 1) PG8_BAR; }
    }
    PG8_WAIT_V(0);
    if constexpr (!ALIGN_EPI) { if (wr == 0) PG8_BAR; }
    PG8_BAR;
    if constexpr (Epi::AFTER_DRAIN) { E.fused(acc, cur, wr, wc, fr, fq, lds, wid, lane); S.done(cur); }
#undef PG8_SA
#undef PG8_SB
#undef PG8_STAGE
#undef PG8_LDA
#undef PG8_LDB
#undef PG8_MMA
#undef PG8_WAIT_V
#undef PG8_WAIT_L
#undef PG8_BAR
#undef PG8_SCHED
}
}
#define DI __device__ __forceinline__
#define LAS __attribute__((address_space(3)))
typedef unsigned short bf16_t;
typedef short bf16x8 __attribute__((ext_vector_type(8)));
typedef short s16x4 __attribute__((ext_vector_type(4)));
typedef float f32x4 __attribute__((ext_vector_type(4)));
typedef float f32x16 __attribute__((ext_vector_type(16)));
typedef unsigned u32x4 __attribute__((ext_vector_type(4)));
typedef unsigned u32x2 __attribute__((ext_vector_type(2)));
#define MFMA32(a, b, c) __builtin_amdgcn_mfma_f32_32x32x16_bf16((a), (b), (c), 0, 0, 0)

constexpr int T_TOK = 16384, DM = 2048, SEQ = 4096, PIN = 7168, FF = 5632, FF2 = 11264, MODW = 12288;
constexpr float EPS = 1e-6f;
constexpr size_t MiB = 1u << 20;
constexpr size_t WS_MODP = 0, WS_MOD = 6 * MiB, WS_DEC = 7 * MiB, WS_STATS = 8 * MiB;
constexpr size_t WS_W = 16 * MiB;
constexpr size_t WS_WA = WS_W, WS_WO = WS_W + 28 * MiB, WS_WU = WS_WO + 8 * MiB, WS_WD = WS_WU + 44 * MiB;
constexpr size_t WS_HY = 118 * MiB;
constexpr size_t WS_BIG = 182 * MiB;
constexpr size_t WS_XB = WS_BIG;
constexpr size_t WS_Z = WS_BIG + 64 * MiB;
constexpr size_t WS_UT = WS_BIG + 224 * MiB;
constexpr size_t WS_U = 534 * MiB;
constexpr size_t WS_VT = WS_U, WS_ST = WS_U + 32 * MiB;
constexpr size_t WS_END = 710 * MiB;
constexpr int LDS_BYTES = 147456;

struct P {
    const float *x, *c, *ada_w, *ada_b, *mix_norm, *ffn_norm, *par_w_in, *par_w_out, *lb_logits, *hg_out_norm, *sg_w_in, *sg_v_gain, *sg_v_bias, *sg_w_pos, *sg_b_pos, *sg_w_out,
        *ffn_up, *conv_w, *conv_b, *ffn_down, *final_norm;
    float* out; unsigned char* ws;
};

DI unsigned pk2(float lo, float hi) { return pg8::cvt_pk_bf16(lo, hi); }
DI bf16_t f2bf(float x) { return (bf16_t)(pk2(x, 0.f) & 0xffffu); }
DI float bf2f(unsigned v) { return __uint_as_float(v << 16); }
DI float bflo(unsigned w) { return __uint_as_float(w << 16); }
DI float bfhi(unsigned w) { return __uint_as_float(w & 0xffff0000u); }
DI float wave_sum(float v) {
#pragma unroll
    for (int o = 1; o < 64; o <<= 1) v += __shfl_xor(v, o);
    return v;
}
DI int crow(int reg, int h) { return (reg & 3) + 8 * (reg >> 2) + 4 * h; }
DI f32x16 zero16() { f32x16 z;
#pragma unroll
    for (int i = 0; i < 16; ++i) z[i] = 0.f;
    return z; }
DI bf16x8 pack_step(const f32x16& x, int s) {
    u32x4 p; p.x = pk2(x[8 * s], x[8 * s + 1]); p.y = pk2(x[8 * s + 2], x[8 * s + 3]); p.z = pk2(x[8 * s + 4], x[8 * s + 5]); p.w = pk2(x[8 * s + 6], x[8 * s + 7]);
    return __builtin_bit_cast(bf16x8, p);
}

DI void transpose_item(const float* W, int K, int N, bf16_t* WT, LAS float* scr, int item, int lane, bool gv = false) {
    const int nblk = N / 32, kb = item / nblk, nb = item % nblk, k0 = 64 * kb, n0 = 32 * nb;
    const int nd0 = !gv ? n0 : (n0 < FF ? 256 * (n0 >> 7) + (n0 & 127) : 256 * ((n0 - FF) >> 7) + 128 + ((n0 - FF) & 127));
#pragma unroll 8
    for (int i = 0; i < 32; ++i) { const int kk = 2 * i + (lane >> 5); scr[kk * 33 + (lane & 31)] = W[(size_t)(k0 + kk) * N + n0 + (lane & 31)]; }
    asm volatile("s_waitcnt lgkmcnt(0)" ::: "memory");
    const int c = lane & 7;
#pragma unroll
    for (int j = 0; j < 4; ++j) { const int n = (lane >> 3) + 8 * j; const LAS float* s = scr + (8 * c) * 33 + n;
        u32x4 o; o.x = pk2(s[0 * 33], s[1 * 33]); o.y = pk2(s[2 * 33], s[3 * 33]); o.z = pk2(s[4 * 33], s[5 * 33]); o.w = pk2(s[6 * 33], s[7 * 33]);
        *(u32x4*)(WT + (size_t)(nd0 + n) * K + k0 + 8 * c) = o; }
    asm volatile("s_waitcnt lgkmcnt(0)" ::: "memory");
}
DI void convert_weights(const P& p, int layer, LAS unsigned char* L, int gw, int ngw, int wave, int lane) {
    LAS float* scr = (LAS float*)(L + wave * 16384);
    const float* w0 = layer ? p.sg_w_in : p.par_w_in; const int n0 = layer ? 4096 : PIN;
    const float* w1 = layer ? p.sg_w_out : p.par_w_out;
    const float* w2 = p.ffn_up + (size_t)layer * DM * FF2;
    const float* w3 = p.ffn_down + (size_t)layer * FF * DM;
    const int I0 = 32 * (n0 / 32), I1 = 32 * 64, I2 = 32 * (FF2 / 32), I3 = (FF / 64) * 64;
    for (int it = gw; it < I0 + I1 + I2 + I3; it += ngw) {
        int r = it;
        if (r < I0) { transpose_item(w0, DM, n0, (bf16_t*)(p.ws + WS_WA), scr, r, lane); continue; } r -= I0;
        if (r < I1) { transpose_item(w1, DM, DM, (bf16_t*)(p.ws + WS_WO), scr, r, lane); continue; } r -= I1;
        if (r < I2) { transpose_item(w2, DM, FF2, (bf16_t*)(p.ws + WS_WU), scr, r, lane, true); continue; } r -= I2;
        transpose_item(w3, FF, DM, (bf16_t*)(p.ws + WS_WD), scr, r, lane);
    }
}
DI void ada_partials(const P& p, LAS unsigned char* L) {
    LAS float* condl = (LAS float*)(L + 8 * 16384);
    float* modp = (float*)(p.ws + WS_MODP);
    const int tid = opaque_tid();
    for (int item = blockIdx.x; item < 768; item += gridDim.x) {
        const int l = item / 384, r = item % 384, cb = r / 16, ks = r % 16;
        __syncthreads();
        { const int b = tid >> 7, k = tid & 127; const float cv = p.c[b * DM + ks * 128 + k]; condl[tid] = cv * __builtin_amdgcn_rcpf(1.f + __expf(-cv)); }
        __syncthreads();
        const int col = cb * 512 + tid;
        const float* w = p.ada_w + ((size_t)l * DM + ks * 128) * MODW + col;
        float a0 = 0.f, a1 = 0.f, a2 = 0.f, a3 = 0.f;
#pragma unroll 8
        for (int k = 0; k < 128; ++k) { const float wv = w[(size_t)k * MODW]; a0 += condl[k] * wv; a1 += condl[128 + k] * wv; a2 += condl[256 + k] * wv; a3 += condl[384 + k] * wv; }
        float* o = modp + ((size_t)(ks * 2 + l) * 4) * MODW + col;
        o[0] = a0; o[MODW] = a1; o[2 * MODW] = a2; o[3 * MODW] = a3;
    }
}
DI void mod_reduce(const P& p) {
    const float* modp = (const float*)(p.ws + WS_MODP); float* mod = (float*)(p.ws + WS_MOD);
    for (int idx = blockIdx.x * 512 + opaque_tid(); idx < 2 * 4 * MODW; idx += gridDim.x * 512) {
        const int l = idx / (4 * MODW), col = idx % MODW; float s = p.ada_b[l * MODW + col];
#pragma unroll
        for (int ks = 0; ks < 16; ++ks) s += modp[(size_t)ks * (2 * 4 * MODW) + idx];
        mod[idx] = s;
    }
}
DI void norm_rows(const float* X, const float* gain, const float* sh, const float* sc, bf16_t* H, int gw, int ngw, int lane) {
    for (int m = gw; m < T_TOK; m += ngw) {
        const int b = m >> 12;
        const f32x4* xr = (const f32x4*)(X + (size_t)m * DM) + lane;
        f32x4 v[8]; float s = 0.f;
#pragma unroll
        for (int j = 0; j < 8; ++j) { v[j] = xr[64 * j]; s += (v[j].x * v[j].x + v[j].y * v[j].y) + (v[j].z * v[j].z + v[j].w * v[j].w); }
        const float rstd = rsqrtf(wave_sum(s) * (1.f / DM) + EPS);
        const f32x4* gp = (const f32x4*)gain + lane; const f32x4* scp = (const f32x4*)(sc + (size_t)b * MODW) + lane; const f32x4* shp = (const f32x4*)(sh + (size_t)b * MODW) + lane;
        u32x2* o = (u32x2*)(H + (size_t)m * DM) + lane;
#pragma unroll
        for (int j = 0; j < 8; ++j) { const f32x4 r = v[j] * rstd * gp[64 * j] * (scp[64 * j] + 1.0f) + shp[64 * j]; u32x2 w; w.x = pk2(r.x, r.y); w.y = pk2(r.z, r.w); o[64 * j] = w; }
    }
}
DI void final_norm_rows(float* X, const float* gain, int gw, int ngw, int lane) {
    for (int m = gw; m < T_TOK; m += ngw) {
        f32x4* xr = (f32x4*)(X + (size_t)m * DM) + lane;
        f32x4 v[8]; float s = 0.f;
#pragma unroll
        for (int j = 0; j < 8; ++j) { v[j] = xr[64 * j]; s += (v[j].x * v[j].x + v[j].y * v[j].y) + (v[j].z * v[j].z + v[j].w * v[j].w); }
        const float rstd = rsqrtf(wave_sum(s) * (1.f / DM) + EPS);
        const f32x4* gp = (const f32x4*)gain + lane;
#pragma unroll
        for (int j = 0; j < 8; ++j) xr[64 * j] = v[j] * rstd * gp[64 * j];
    }
}
DI void unpack8(const u32x4 w, float (&f)[8]) { f[0] = bflo(w.x); f[1] = bfhi(w.x); f[2] = bflo(w.y); f[3] = bfhi(w.y); f[4] = bflo(w.z); f[5] = bfhi(w.z); f[6] = bflo(w.w); f[7] = bfhi(w.w); }
DI void ld8f(const float* p, float (&f)[8]) { const f32x4 a = *(const f32x4*)p, b = *(const f32x4*)(p + 4); f[0] = a.x; f[1] = a.y; f[2] = a.z; f[3] = a.w; f[4] = b.x; f[5] = b.y; f[6] = b.z; f[7] = b.w; }
DI void conv_act(const bf16_t* A, const float* cw, const float* cb, bf16_t* U) {
    const int total = (T_TOK / 8) * (FF / 8);
    for (int it = blockIdx.x * 512 + opaque_tid(); it < total; it += gridDim.x * 512) {
        const int j8 = it % (FF / 8), tb = it / (FF / 8), j = j8 * 8, t0 = tb * 8;
        float wg0[8], wg1[8], wg2[8], wv0[8], wv1[8], wv2[8], bg[8], bv[8];
        ld8f(cw + j, wg0); ld8f(cw + FF2 + j, wg1); ld8f(cw + 2 * FF2 + j, wg2);
        ld8f(cw + FF + j, wv0); ld8f(cw + FF2 + FF + j, wv1); ld8f(cw + 2 * FF2 + FF + j, wv2);
        ld8f(cb + j, bg); ld8f(cb + FF + j, bv);
        float g2[8], g1[8], v2[8], v1[8];
        if ((t0 & (SEQ - 1)) == 0) {
#pragma unroll
            for (int e = 0; e < 8; ++e) { g2[e] = 0.f; g1[e] = 0.f; v2[e] = 0.f; v1[e] = 0.f; }
        } else {
            unpack8(*(const u32x4*)(A + (size_t)(t0 - 2) * FF2 + j), g2); unpack8(*(const u32x4*)(A + (size_t)(t0 - 1) * FF2 + j), g1);
            unpack8(*(const u32x4*)(A + (size_t)(t0 - 2) * FF2 + FF + j), v2); unpack8(*(const u32x4*)(A + (size_t)(t0 - 1) * FF2 + FF + j), v1);
        }
#pragma unroll
        for (int i = 0; i < 8; ++i) {
            float g0[8], v0[8];
            unpack8(*(const u32x4*)(A + (size_t)(t0 + i) * FF2 + j), g0); unpack8(*(const u32x4*)(A + (size_t)(t0 + i) * FF2 + FF + j), v0);
            float o[8];
#pragma unroll
            for (int e = 0; e < 8; ++e) {
                const float ag = bg[e] + wg0[e] * g2[e] + wg1[e] * g1[e] + wg2[e] * g0[e];
                const float av = bv[e] + wv0[e] * v2[e] + wv1[e] * v1[e] + wv2[e] * v0[e];
                o[e] = ag * __builtin_amdgcn_rcpf(1.f + __expf(-ag)) * av;
                g2[e] = g1[e]; g1[e] = g0[e]; v2[e] = v1[e]; v1[e] = v0[e];
            }
            u32x4 w; w.x = pk2(o[0], o[1]); w.y = pk2(o[2], o[3]); w.z = pk2(o[4], o[5]); w.w = pk2(o[6], o[7]);
            *(u32x4*)(U + (size_t)(t0 + i) * FF + j) = w;
        }
    }
}
DI void conv_fixup(const float* SB, const float* cw, const float* cb, bf16_t* U) {
    for (int it = blockIdx.x * 512 + opaque_tid(); it < 64 * (FF / 4); it += gridDim.x * 512) {
        const int pm = it / (FF / 4), j = (it % (FF / 4)) * 4;
        const int tc = 256 * (j >> 7) + (j & 127);
        const f32x4 zero4 = {0.f, 0.f, 0.f, 0.f};
        const bool head = (pm & 15) == 0;
        const float* s0 = SB + (size_t)(pm * 4) * FF2 + tc; const float* sp = SB + (size_t)((pm - 1) * 4) * FF2 + tc;
        const f32x4 g0 = *(const f32x4*)(s0), g1 = *(const f32x4*)(s0 + FF2), v0 = *(const f32x4*)(s0 + 128), v1 = *(const f32x4*)(s0 + FF2 + 128);
        const f32x4 gA = head ? zero4 : *(const f32x4*)(sp + 2 * FF2), gB = head ? zero4 : *(const f32x4*)(sp + 3 * FF2);
        const f32x4 vA = head ? zero4 : *(const f32x4*)(sp + 2 * FF2 + 128), vB = head ? zero4 : *(const f32x4*)(sp + 3 * FF2 + 128);
        const f32x4 wg0 = *(const f32x4*)(cw + j), wg1 = *(const f32x4*)(cw + FF2 + j), wg2 = *(const f32x4*)(cw + 2 * FF2 + j), bg = *(const f32x4*)(cb + j);
        const f32x4 wv0 = *(const f32x4*)(cw + FF + j), wv1 = *(const f32x4*)(cw + FF2 + FF + j), wv2 = *(const f32x4*)(cw + 2 * FF2 + FF + j), bv = *(const f32x4*)(cb + FF + j);
        const f32x4 ag0 = bg + wg0 * gA + wg1 * gB + wg2 * g0, av0 = bv + wv0 * vA + wv1 * vB + wv2 * v0;
        const f32x4 ag1 = bg + wg0 * gB + wg1 * g0 + wg2 * g1, av1 = bv + wv0 * vB + wv1 * v0 + wv2 * v1;
        float r0[4], r1[4];
#pragma unroll
        for (int e = 0; e < 4; ++e) { r0[e] = ag0[e] * __builtin_amdgcn_rcpf(1.f + __expf(-ag0[e])) * av0[e]; r1[e] = ag1[e] * __builtin_amdgcn_rcpf(1.f + __expf(-ag1[e])) * av1[e]; }
        u32x2 o; o.x = pk2(r0[0], r0[1]); o.y = pk2(r0[2], r0[3]); *(u32x2*)(U + (size_t)(pm * 256) * FF + j) = o;
        o.x = pk2(r1[0], r1[1]); o.y = pk2(r1[2], r1[3]); *(u32x2*)(U + (size_t)(pm * 256 + 1) * FF + j) = o;
    }
}
DI void v_transpose(const bf16_t* PROJ, bf16_t* VT, LAS unsigned char* L) {
    const int tid = opaque_tid();
    for (int item = blockIdx.x; item < 1024; item += gridDim.x) {
        const int bh = item >> 5, sb = item & 31, b = bh >> 3, hh = bh & 7;
        __syncthreads();
#pragma unroll
        for (int j = 0; j < 4; ++j) { const int c = tid + 512 * j, s = c >> 4, d8 = c & 15;
            const u32x4 v = *(const u32x4*)(PROJ + ((size_t)b * SEQ + sb * 128 + s) * PIN + 2048 + hh * 128 + d8 * 8);
            *(LAS u32x4*)(L + s * 272 + d8 * 16) = v; }
        __syncthreads();
#pragma unroll
        for (int j = 0; j < 4; ++j) { const int c = tid + 512 * j, d = c >> 4, s8 = c & 15;
            unsigned e[8];
#pragma unroll
            for (int i = 0; i < 8; ++i) e[i] = *(const LAS bf16_t*)(L + (s8 * 8 + i) * 272 + d * 2);
            u32x4 o; o.x = e[0] | (e[1] << 16); o.y = e[2] | (e[3] << 16); o.z = e[4] | (e[5] << 16); o.w = e[6] | (e[7] << 16);
            *(u32x4*)(VT + ((size_t)bh * 128 + d) * SEQ + sb * 128 + s8 * 8) = o; }
    }
}
DI void hg_gates(const LAS unsigned char* rawf, const float* lbl, int part, int hh, int d, float (&G)[16], float (&kk)[16]) {
    const float l0 = lbl[hh * 128 + d], l1 = lbl[1024 + hh * 128 + d]; const float lb = __builtin_amdgcn_rcpf(1.f + __expf(l1 - l0));
    float run = 0.f;
#pragma unroll
    for (int i = 0; i < 16; ++i) {
        const float fl = bf2f(*(const LAS bf16_t*)(rawf + (16 * part + i) * 272 + d * 2));
        const float sig = __builtin_amdgcn_rcpf(1.f + __expf(-fl)); const float f = lb + (1.f - lb) * sig;
        kk[i] = (1.f - lb) * (1.f - sig); run += __builtin_amdgcn_logf(f) * 0.69314718056f; G[i] = run;
    }
}
DI void hg_raw_load(const bf16_t* PROJ, int ch, int colbase, unsigned roff, u32x4 (&rg)[2]) {
    const int bh = ch >> 6, n = ch & 63, b = bh >> 3, hh = bh & 7;
    const bf16_t* src = PROJ + ((size_t)b * SEQ + n * 64) * PIN + colbase + hh * 128;
    rg[0] = *(const u32x4*)(src + roff); rg[1] = *(const u32x4*)(src + (size_t)32 * PIN + roff);
}
DI void hg_raw_store(LAS unsigned char* img, int tid, const u32x4 (&rg)[2]) {
    LAS unsigned char* wp = img + (tid >> 4) * 272 + (tid & 15) * 16;
    *(LAS u32x4*)wp = rg[0]; *(LAS u32x4*)(wp + 32 * 272) = rg[1];
}
DI void hg_col16(const LAS unsigned char* img, int part, int d, u32x4& a, u32x4& c) {
    unsigned e[16];
#pragma unroll
    for (int i = 0; i < 16; ++i) e[i] = *(const LAS bf16_t*)(img + (16 * part + i) * 272 + d * 2);
    a.x = e[0] | (e[1] << 16); a.y = e[2] | (e[3] << 16); a.z = e[4] | (e[5] << 16); a.w = e[6] | (e[7] << 16);
    c.x = e[8] | (e[9] << 16); c.y = e[10] | (e[11] << 16); c.z = e[12] | (e[13] << 16); c.w = e[14] | (e[15] << 16);
}
DI void hg_phase_a(const P& p, const bf16_t* PROJ, float* UT, float* DEC, LAS unsigned char* L) {
    const int tid = opaque_tid(), w = __builtin_amdgcn_readfirstlane(tid >> 6), lane = tid & 63, r = lane & 31, lh = lane >> 5;
    LAS unsigned char* kendT = L; LAS unsigned char* vT = L + 18432; LAS float* psum = (LAS float*)(L + 36864);
    LAS unsigned char* rawf = L + 40960; LAS unsigned char* rawv = L + 40960 + 17408;
    const int d = tid & 127, part = tid >> 7;
    const unsigned roff = (unsigned)((tid >> 4) * PIN + (tid & 15) * 8);
    u32x4 rf[2], rv[2];
    if ((int)blockIdx.x < 2048) { hg_raw_load(PROJ, blockIdx.x, 4096, roff, rf); hg_raw_load(PROJ, blockIdx.x, 5120, roff, rv); }
    for (int ch = blockIdx.x; ch < 2048; ch += gridDim.x) {
        const int bh = ch >> 6, hh = bh & 7;
        __syncthreads();
        hg_raw_store(rawf, tid, rf); hg_raw_store(rawv, tid, rv);
        if (ch + (int)gridDim.x < 2048) { hg_raw_load(PROJ, ch + gridDim.x, 4096, roff, rf); hg_raw_load(PROJ, ch + gridDim.x, 5120, roff, rv); }
        __syncthreads();
        float G[16], kk[16];
        hg_gates(rawf, p.lb_logits, part, hh, d, G, kk);
        psum[part * 128 + d] = G[15];
        { u32x4 a, c; hg_col16(rawv, part, d, a, c); *(LAS u32x4*)(vT + d * 144 + part * 32) = a; *(LAS u32x4*)(vT + d * 144 + part * 32 + 16) = c; }
        __syncthreads();
        float off = 0.f, tot = 0.f;
#pragma unroll
        for (int q = 0; q < 4; ++q) { const float v = psum[q * 128 + d]; tot += v; off += (q < part) ? v : 0.f; }
        { float ke[16];
#pragma unroll
          for (int i = 0; i < 16; ++i) ke[i] = kk[i] * __expf(tot - (off + G[i]));
          u32x4 a, c; a.x = pk2(ke[0], ke[1]); a.y = pk2(ke[2], ke[3]); a.z = pk2(ke[4], ke[5]); a.w = pk2(ke[6], ke[7]);
          c.x = pk2(ke[8], ke[9]); c.y = pk2(ke[10], ke[11]); c.z = pk2(ke[12], ke[13]); c.w = pk2(ke[14], ke[15]);
          *(LAS u32x4*)(kendT + d * 144 + part * 32) = a; *(LAS u32x4*)(kendT + d * 144 + part * 32 + 16) = c; }
        if (part == 0) DEC[(size_t)ch * 128 + d] = __expf(tot);
        __syncthreads();
        const int dvt = w >> 1, dkt0 = (w & 1) * 2;
        f32x16 acc0 = zero16(), acc1 = zero16();
#pragma unroll
        for (int ks = 0; ks < 4; ++ks) {
            const bf16x8 a = *(const LAS bf16x8*)(vT + (32 * dvt + r) * 144 + (16 * ks + 8 * lh) * 2);
            const bf16x8 b0 = *(const LAS bf16x8*)(kendT + (32 * dkt0 + r) * 144 + (16 * ks + 8 * lh) * 2);
            const bf16x8 b1 = *(const LAS bf16x8*)(kendT + (32 * (dkt0 + 1) + r) * 144 + (16 * ks + 8 * lh) * 2);
            acc0 = MFMA32(a, b0, acc0); acc1 = MFMA32(a, b1, acc1);
        }
        float* o = UT + (size_t)ch * 16384;
#pragma unroll
        for (int reg = 0; reg < 16; ++reg) { const int dv = 32 * dvt + crow(reg, lh); o[dv * 128 + 32 * dkt0 + r] = acc0[reg]; o[dv * 128 + 32 * (dkt0 + 1) + r] = acc1[reg]; }
    }
}
DI void hg_phase_b(const float* UT, const float* DEC, bf16_t* ST) {
    for (int idx = blockIdx.x * 512 + opaque_tid(); idx < 32 * 4096; idx += gridDim.x * 512) {
        const int bh = idx >> 12, rem = idx & 4095, dv = rem >> 5, dk4 = (rem & 31) * 4;
        f32x4 st = {0.f, 0.f, 0.f, 0.f};
#pragma unroll 4
        for (int n = 0; n < 64; ++n) {
            const size_t ch = (size_t)bh * 64 + n;
            u32x2 w; w.x = pk2(st.x, st.y); w.y = pk2(st.z, st.w);
            *(u32x2*)(ST + ch * 16384 + dv * 128 + dk4) = w;
            const f32x4 u = *(const f32x4*)(UT + ch * 16384 + dv * 128 + dk4), dc = *(const f32x4*)(DEC + ch * 128 + dk4);
            st = dc * st + u;
        }
    }
}
DI void hg_phase_c(const P& p, const bf16_t* PROJ, const bf16_t* ST, bf16_t* Y, LAS unsigned char* L, unsigned* qcnt) {
    const int tid = opaque_tid(), w = __builtin_amdgcn_readfirstlane(tid >> 6), lane = tid & 63, r = lane & 31, lh = lane >> 5;
    LAS unsigned char* qd = L; LAS unsigned char* ki = L + 17408; LAS unsigned char* vT = L + 34816; LAS float* psum = (LAS float*)(L + 52224); LAS float* rp = (LAS float*)(L + 54272);
    LAS unsigned char* rawf = L + 57344; LAS unsigned char* rawv = rawf + 17408; LAS unsigned char* rawq = rawv + 17408;
    const int d = tid & 127, part = tid >> 7;
    const unsigned roff = (unsigned)((tid >> 4) * PIN + (tid & 15) * 8);
    u32x4 rf[2], rv[2], rq[2];
    LAS unsigned* qs = (LAS unsigned*)(L + 139424);
    __syncthreads();
    if (tid == 0) qs[0] = __hip_atomic_fetch_add(qcnt, 1u, __ATOMIC_RELAXED, __HIP_MEMORY_SCOPE_AGENT);
    __syncthreads();
    int ch = (int)qs[0], par = 0;
    if (ch < 2048) { hg_raw_load(PROJ, ch, 4096, roff, rf); hg_raw_load(PROJ, ch, 5120, roff, rv); hg_raw_load(PROJ, ch, 3072, roff, rq); }
    while (ch < 2048) {
        const int bh = ch >> 6, n = ch & 63, b = bh >> 3, hh = bh & 7;
        if (tid == 0) qs[par ^ 1] = __hip_atomic_fetch_add(qcnt, 1u, __ATOMIC_RELAXED, __HIP_MEMORY_SCOPE_AGENT);
        __syncthreads();
        const int nxt = (int)qs[par ^ 1];
        hg_raw_store(rawf, tid, rf); hg_raw_store(rawv, tid, rv); hg_raw_store(rawq, tid, rq);
        if (nxt < 2048) { hg_raw_load(PROJ, nxt, 4096, roff, rf); hg_raw_load(PROJ, nxt, 5120, roff, rv); hg_raw_load(PROJ, nxt, 3072, roff, rq); }
        __syncthreads();
        const int dt = w & 3, tt = w >> 2;
        bf16x8 stf[8];
        { const bf16_t* STc = ST + (size_t)ch * 16384 + (32 * dt + r) * 128 + 8 * lh;
#pragma unroll
          for (int ks = 0; ks < 8; ++ks) stf[ks] = *(const bf16x8*)(STc + 16 * ks); }
        const size_t trow = (size_t)b * SEQ + n * 64 + 32 * tt + r;
        u32x2 ggv[4]; f32x4 ogv[4];
#pragma unroll
        for (int g4 = 0; g4 < 4; ++g4) { const int dv0 = 32 * dt + 8 * g4 + 4 * lh; ggv[g4] = *(const u32x2*)(PROJ + trow * PIN + 6144 + hh * 128 + dv0); ogv[g4] = *(const f32x4*)(p.hg_out_norm + hh * 128 + dv0); }
        float G[16], kk[16];
        hg_gates(rawf, p.lb_logits, part, hh, d, G, kk);
        psum[part * 128 + d] = G[15];
        { u32x4 a, c; hg_col16(rawv, part, d, a, c);
          u32x2 t2; t2.x = a.x; t2.y = a.y; *(LAS u32x2*)(vT + d * 136 + part * 32) = t2; t2.x = a.z; t2.y = a.w; *(LAS u32x2*)(vT + d * 136 + part * 32 + 8) = t2;
          t2.x = c.x; t2.y = c.y; *(LAS u32x2*)(vT + d * 136 + part * 32 + 16) = t2; t2.x = c.z; t2.y = c.w; *(LAS u32x2*)(vT + d * 136 + part * 32 + 24) = t2; }
        float qs[16];
#pragma unroll
        for (int i = 0; i < 16; ++i) { const float ql = bf2f(*(const LAS bf16_t*)(rawq + (16 * part + i) * 272 + d * 2)); qs[i] = ql * __builtin_amdgcn_rcpf(1.f + __expf(-ql)); }
        __syncthreads();
        float off = 0.f;
#pragma unroll
        for (int q = 0; q < 4; ++q) { const float v = psum[q * 128 + d]; off += (q < part) ? v : 0.f; }
#pragma unroll
        for (int i = 0; i < 16; ++i) { const float g = off + G[i];
            *(LAS bf16_t*)(qd + (16 * part + i) * 272 + d * 2) = f2bf(qs[i] * __expf(g));
            *(LAS bf16_t*)(ki + (16 * part + i) * 272 + d * 2) = f2bf(kk[i] * __expf(-g)); }
        __syncthreads();
        bf16x8 qfr[8];
#pragma unroll
        for (int ks = 0; ks < 8; ++ks) qfr[ks] = *(const LAS bf16x8*)(qd + (32 * tt + r) * 272 + (16 * ks + 8 * lh) * 2);
        f32x16 O = zero16();
#pragma unroll
        for (int st = 0; st < 2; ++st) {
            if (st <= tt) {
                f32x16 X = zero16();
#pragma unroll
                for (int ks = 0; ks < 8; ++ks) { const bf16x8 a = *(const LAS bf16x8*)(ki + (32 * st + r) * 272 + (16 * ks + 8 * lh) * 2); X = MFMA32(a, qfr[ks], X); }
                if (st == tt) {
#pragma unroll
                    for (int reg = 0; reg < 16; ++reg) X[reg] = (crow(reg, lh) > r) ? 0.f : X[reg];
                }
#pragma unroll
                for (int sp = 0; sp < 2; ++sp) {
                    const bf16x8 pf = pack_step(X, sp);
                    const s16x4 lo = *(const LAS s16x4*)(vT + (32 * dt + r) * 136 + (32 * st + 16 * sp + 4 * lh) * 2);
                    const s16x4 hi = *(const LAS s16x4*)(vT + (32 * dt + r) * 136 + (32 * st + 16 * sp + 4 * lh) * 2 + 16);
                    O = MFMA32(__builtin_shufflevector(lo, hi, 0, 1, 2, 3, 4, 5, 6, 7), pf, O);
                }
            }
        }
#pragma unroll
        for (int ks = 0; ks < 8; ++ks) O = MFMA32(stf[ks], qfr[ks], O);
        float ss = 0.f;
#pragma unroll
        for (int reg = 0; reg < 16; ++reg) ss += O[reg] * O[reg];
        ss += __shfl_xor(ss, 32);
        if (lh == 0) rp[dt * 64 + 32 * tt + r] = ss;
        __syncthreads();
        const float tot = (rp[32 * tt + r] + rp[64 + 32 * tt + r]) + (rp[128 + 32 * tt + r] + rp[192 + 32 * tt + r]);
        const float rstd = rsqrtf(tot * (1.f / 128.f) + EPS);
#pragma unroll
        for (int g4 = 0; g4 < 4; ++g4) {
            const int dv0 = 32 * dt + 8 * g4 + 4 * lh;
            const u32x2 gg = ggv[g4];
            const f32x4 og = ogv[g4];
            const float g0 = bflo(gg.x), g1 = bfhi(gg.x), g2 = bflo(gg.y), g3 = bfhi(gg.y);
            const float o0 = O[4 * g4] * rstd * og.x * (g0 * __builtin_amdgcn_rcpf(1.f + __expf(-g0))), o1 = O[4 * g4 + 1] * rstd * og.y * (g1 * __builtin_amdgcn_rcpf(1.f + __expf(-g1)));
            const float o2 = O[4 * g4 + 2] * rstd * og.z * (g2 * __builtin_amdgcn_rcpf(1.f + __expf(-g2))), o3 = O[4 * g4 + 3] * rstd * og.w * (g3 * __builtin_amdgcn_rcpf(1.f + __expf(-g3)));
            u32x2 wv; wv.x = pk2(o0, o1); wv.y = pk2(o2, o3);
            *(u32x2*)(Y + trow * DM + 1024 + hh * 128 + dv0) = wv;
        }
        ch = nxt; par ^= 1;
    }
}
template <bool DIAG> DI void sb_elem(f32x16& X, float& run, int tr, bool lh0) {
    const float scale2 = 0.08838834764831845f * 1.4426950408889634f;
    f32x16 KP; float gp[4], pg[4];
#pragma unroll
    for (int g = 0; g < 4; ++g) {
        float a0 = 1.f;
#pragma unroll
        for (int i = 0; i < 4; ++i) { const int reg = 4 * g + i;
            const float z2 = X[reg] * scale2; const float e = __builtin_amdgcn_exp2f(-__builtin_fabsf(z2)); const float inv = __builtin_amdgcn_rcpf(1.f + e);
            float keep = (z2 >= 0.f) ? e * inv : inv;
            if (DIAG) keep = (8 * g + i < tr) ? keep : 1.f;
            KP[reg] = keep; a0 *= keep; }
        gp[g] = a0;
    }
#pragma unroll
    for (int g = 0; g < 4; ++g) pg[g] = __shfl_xor(gp[g], 32);
#pragma unroll
    for (int g = 3; g >= 0; --g) {
        float c = lh0 ? run * pg[g] : run;
#pragma unroll
        for (int i = 3; i >= 0; --i) { const int reg = 4 * g + i; const float cn = c * KP[reg]; X[reg] = c - cn; c = cn; }
        run *= gp[g] * pg[g];
    }
}
DI void attn_phase(const bf16_t* PROJ, const bf16_t* VT, bf16_t* Y, LAS unsigned char* L, unsigned* qcnt) {
    const int tid = opaque_tid(), w = __builtin_amdgcn_readfirstlane(tid >> 6), lane = tid & 63, r = lane & 31, lh = lane >> 5;
    constexpr int ATT_BUF = 34816;
    LAS unsigned char* Kt = L; LAS unsigned char* Vt = L + 17408; LAS unsigned char* Qs = L + 2 * ATT_BUF;
    const unsigned koff = (unsigned)((tid >> 4) * PIN + (tid & 15) * 8), voff = (unsigned)((tid >> 3) * SEQ + (tid & 7) * 8);
    const unsigned yoff = (unsigned)((32 * w + r) * DM + 4 * lh);
    const float lhm = lh == 0 ? 1.f : 0.f;
    LAS unsigned* qslot = (LAS unsigned*)(L + 139392);
    for (;;) {
        {
            __syncthreads();
            if (tid == 0) *qslot = __hip_atomic_fetch_add(qcnt, 1u, __ATOMIC_RELAXED, __HIP_MEMORY_SCOPE_AGENT);
            __syncthreads();
            const int unit = (int)*qslot;
            if (unit >= 512) break;
            const int qb = 15 - (unit >> 5), bh = unit & 31, b = bh >> 3, hh = bh & 7, q0 = qb * 256;
            const size_t rowb = (size_t)b * SEQ;
            const int t = q0 + 32 * w + r;
            { const bf16_t* qp = PROJ + (rowb + q0) * PIN + hh * 128; LAS unsigned char* qwr = Qs + (tid >> 4) * 272 + (tid & 15) * 16;
#pragma unroll
              for (int j = 0; j < 8; ++j) *(LAS u32x4*)(qwr + j * 32 * 272) = *(const u32x4*)(qp + (size_t)j * 32 * PIN + koff); }
            const LAS unsigned char* qrd = Qs + (32 * w + r) * 272 + lh * 16;
            f32x16 O0 = zero16(), O1 = zero16(), O2 = zero16(), O3 = zero16();
            float R = 1.f;
            const int nkt = 4 * qb + 4;
            u32x4 kreg[2], vreg[2];
            const bf16_t* kb0 = PROJ + rowb * PIN + 1024 + hh * 128; const bf16_t* vb0 = VT + (size_t)bh * 128 * SEQ;
            LAS unsigned char* kwr = Kt + (tid >> 4) * 272 + (tid & 15) * 16; LAS unsigned char* vwr = Vt + (tid >> 3) * 136 + (tid & 7) * 16;
#define ATT_LOAD(ktile) { const bf16_t* kb = kb0 + (size_t)(64 * (ktile)) * PIN; const bf16_t* vb = vb0 + 64 * (ktile); \
              kreg[0] = *(const u32x4*)(kb + koff); kreg[1] = *(const u32x4*)(kb + 32 * PIN + koff); \
              vreg[0] = *(const u32x4*)(vb + voff); vreg[1] = *(const u32x4*)(vb + 64 * SEQ + voff); }
#define ATT_WRITE(bo) { *(LAS u32x4*)(kwr + (bo)) = kreg[0]; *(LAS u32x4*)(kwr + (bo) + 32 * 272) = kreg[1]; \
              u32x2 lo, hi; lo.x = vreg[0].x; lo.y = vreg[0].y; hi.x = vreg[0].z; hi.y = vreg[0].w; *(LAS u32x2*)(vwr + (bo)) = lo; *(LAS u32x2*)(vwr + (bo) + 8) = hi; \
              lo.x = vreg[1].x; lo.y = vreg[1].y; hi.x = vreg[1].z; hi.y = vreg[1].w; *(LAS u32x2*)(vwr + (bo) + 64 * 136) = lo; *(LAS u32x2*)(vwr + (bo) + 64 * 136 + 8) = hi; }
            ATT_LOAD(nkt - 1)
            ATT_WRITE(0)
            ATT_LOAD(nkt - 2)
            __syncthreads();
            int bo = 0; bool walive = true;
            for (int kt = nkt - 1; kt >= 0; --kt, bo ^= ATT_BUF) {
                if (64 * kt <= q0 + 32 * w + 30 && walive) {
                    float run = R;
#pragma unroll
                    for (int st = 1; st >= 0; --st) {
                        f32x16 X = zero16();
#pragma unroll
                        for (int ks = 0; ks < 8; ++ks) {
                            const bf16x8 a = *(const LAS bf16x8*)(Kt + bo + (32 * st + r) * 272 + (16 * ks + 8 * lh) * 2);
                            const bf16x8 qv = *(const LAS bf16x8*)(qrd + 32 * ks);
                            X = MFMA32(a, qv, X);
                        }
                        sb_elem<true>(X, run, t - (64 * kt + 32 * st + 4 * lh), lh == 0);
#pragma unroll
                        for (int sp = 0; sp < 2; ++sp) {
                            const bf16x8 pf = pack_step(X, sp);
                            const int so = (32 * st + 16 * sp + 4 * lh) * 2;
#define ATT_PV(Od, dt) { const s16x4 lo = *(const LAS s16x4*)(Vt + bo + (32 * dt + r) * 136 + so); const s16x4 hi = *(const LAS s16x4*)(Vt + bo + (32 * dt + r) * 136 + so + 16); \
                         Od = MFMA32(__builtin_shufflevector(lo, hi, 0, 1, 2, 3, 4, 5, 6, 7), pf, Od); }
                            ATT_PV(O0, 0) ATT_PV(O1, 1) ATT_PV(O2, 2) ATT_PV(O3, 3)
#undef ATT_PV
                        }
                    }
                    R = run;
                }
                if (kt > 0) { ATT_WRITE(bo ^ ATT_BUF) if (kt > 1) ATT_LOAD(kt - 2) }
                LAS unsigned* vote = (LAS unsigned*)(L + 139296) + (bo ? 8 : 0);
                { const bool any = __ballot(R != 0.f) != 0ull; walive = any; if (lane == 0) vote[w] = any ? 1u : 0u; }
                __syncthreads();
                { const u32x4 v0 = *(const LAS u32x4*)(vote), v1 = *(const LAS u32x4*)(vote + 4);
                  if (((v0.x | v0.y) | (v0.z | v0.w) | (v1.x | v1.y) | (v1.z | v1.w)) == 0u) break; }
            }
#undef ATT_LOAD
#undef ATT_WRITE
            bf16_t* yrow = Y + (rowb + q0) * DM + hh * 128 + yoff;
#pragma unroll
            for (int g = 0; g < 4; ++g) {
                u32x2 v;
                v.x = pk2(O0[4 * g], O0[4 * g + 1]); v.y = pk2(O0[4 * g + 2], O0[4 * g + 3]); *(u32x2*)(yrow + 8 * g) = v;
                v.x = pk2(O1[4 * g], O1[4 * g + 1]); v.y = pk2(O1[4 * g + 2], O1[4 * g + 3]); *(u32x2*)(yrow + 32 + 8 * g) = v;
                v.x = pk2(O2[4 * g], O2[4 * g + 1]); v.y = pk2(O2[4 * g + 2], O2[4 * g + 3]); *(u32x2*)(yrow + 64 + 8 * g) = v;
                v.x = pk2(O3[4 * g], O3[4 * g + 1]); v.y = pk2(O3[4 * g + 2], O3[4 * g + 3]); *(u32x2*)(yrow + 96 + 8 * g) = v;
            }
        }
    }
}
DI void sg_stats(const bf16_t* Z, float* stats, int gw, int ngw, int lane) {
    for (int m = gw; m < T_TOK; m += ngw) {
        const u32x4* zr = (const u32x4*)(Z + (size_t)m * 4096 + 2048) + lane;
        float f[4][8]; float s = 0.f;
#pragma unroll
        for (int j = 0; j < 4; ++j) { unpack8(zr[64 * j], f[j]);
#pragma unroll
            for (int e = 0; e < 8; ++e) s += f[j][e]; }
        const float mean = wave_sum(s) * (1.f / 2048.f); float q = 0.f;
#pragma unroll
        for (int j = 0; j < 4; ++j)
#pragma unroll
            for (int e = 0; e < 8; ++e) { const float dd = f[j][e] - mean; q += dd * dd; }
        const float rstd = rsqrtf(wave_sum(q) * (1.f / 2048.f) + EPS);
        if (lane == 0) { stats[2 * m] = mean; stats[2 * m + 1] = rstd; }
    }
}
DI void sg_mix(const P& p, const bf16_t* Z, const float* stats, bf16_t* Y, LAS unsigned char* L) {
    const int tid = opaque_tid(), w = __builtin_amdgcn_readfirstlane(tid >> 6), lane = tid & 63, r = lane & 31, lh = lane >> 5;
    LAS unsigned char* Wp = L; LAS unsigned char* vT = L + 34816; LAS float* At = (LAS float*)(L + 34816 + 69632); LAS float* Bt = At + 128; LAS unsigned char* rawv = L + 105472;
    const int c = tid & 255, sg = tid >> 8;
    for (int u = blockIdx.x; u < 1024; u += gridDim.x) {
        const int g = u & 7, cn = u >> 3; const size_t base = (size_t)cn * 128;
        u32x4 vq[8];
        { const bf16_t* zp = Z + (base + (tid >> 5)) * 4096 + 2048 + g * 256 + (tid & 31) * 8;
#pragma unroll
          for (int j = 0; j < 8; ++j) vq[j] = *(const u32x4*)(zp + (size_t)(16 * j) * 4096); }
        f32x4 wv[8], st0[8], st1[8];
#pragma unroll
        for (int j = 0; j < 8; ++j) { const int idx = tid + 512 * j, t = idx >> 5, s4 = (idx & 31) * 4;
            wv[j] = *(const f32x4*)(p.sg_w_pos + ((size_t)g * 128 + t) * 128 + s4);
            st0[j] = *(const f32x4*)(stats + 2 * (base + s4)); st1[j] = *(const f32x4*)(stats + 2 * (base + s4) + 4); }
        __syncthreads();
#pragma unroll
        for (int j = 0; j < 8; ++j) { const int idx = tid + 512 * j, t = idx >> 5, s4 = (idx & 31) * 4;
            const float w0 = s4 <= t ? wv[j].x : 0.f, w1 = s4 + 1 <= t ? wv[j].y : 0.f, w2 = s4 + 2 <= t ? wv[j].z : 0.f, w3 = s4 + 3 <= t ? wv[j].w : 0.f;
            u32x2 o; o.x = pk2(w0 * st0[j].y, w1 * st0[j].w); o.y = pk2(w2 * st1[j].y, w3 * st1[j].w);
            *(LAS u32x2*)(Wp + t * 272 + s4 * 2) = o;
            float a = bflo(o.x) * st0[j].x + bfhi(o.x) * st0[j].z + bflo(o.y) * st1[j].x + bfhi(o.y) * st1[j].z;
            float bsum = (w0 + w1) + (w2 + w3);
#define SG_DPP_ADD(x, ctrl) x += __builtin_bit_cast(float, __builtin_amdgcn_update_dpp(__builtin_bit_cast(int, x), __builtin_bit_cast(int, x), ctrl, 0xf, 0xf, false))
            SG_DPP_ADD(a, 0xB1); SG_DPP_ADD(bsum, 0xB1); SG_DPP_ADD(a, 0x4E); SG_DPP_ADD(bsum, 0x4E);
            SG_DPP_ADD(a, 0x141); SG_DPP_ADD(bsum, 0x141); SG_DPP_ADD(a, 0x140); SG_DPP_ADD(bsum, 0x140);
#undef SG_DPP_ADD
            a += __shfl_xor(a, 16); bsum += __shfl_xor(bsum, 16);
            if ((lane & 31) == 0) { At[t] = a; Bt[t] = bsum; } }
#pragma unroll
        for (int hv = 0; hv < 2; ++hv) {
            if (hv) __syncthreads();
#pragma unroll
            for (int j = 0; j < 4; ++j) *(LAS u32x4*)(rawv + ((tid >> 5) + 16 * j) * 528 + (tid & 31) * 16) = vq[4 * hv + j];
            __syncthreads();
#pragma unroll
            for (int k = 0; k < 4; ++k) { unsigned e[8];
#pragma unroll
                for (int i = 0; i < 8; ++i) e[i] = *(const LAS bf16_t*)(rawv + (sg * 32 + 8 * k + i) * 528 + c * 2);
                u32x4 o; o.x = e[0] | (e[1] << 16); o.y = e[2] | (e[3] << 16); o.z = e[4] | (e[5] << 16); o.w = e[6] | (e[7] << 16);
                *(LAS u32x4*)(vT + c * 272 + (64 * hv + sg * 32 + 8 * k) * 2) = o; }
        }
        __syncthreads();
        bf16x8 af[8];
#pragma unroll
        for (int ks = 0; ks < 8; ++ks) af[ks] = *(const LAS bf16x8*)(vT + (32 * w + r) * 272 + (16 * ks + 8 * lh) * 2);
        const f32x4 gam[4] = { *(const f32x4*)(p.sg_v_gain + g * 256 + 32 * w + 4 * lh), *(const f32x4*)(p.sg_v_gain + g * 256 + 32 * w + 8 + 4 * lh),
                               *(const f32x4*)(p.sg_v_gain + g * 256 + 32 * w + 16 + 4 * lh), *(const f32x4*)(p.sg_v_gain + g * 256 + 32 * w + 24 + 4 * lh) };
        const f32x4 bet[4] = { *(const f32x4*)(p.sg_v_bias + g * 256 + 32 * w + 4 * lh), *(const f32x4*)(p.sg_v_bias + g * 256 + 32 * w + 8 + 4 * lh),
                               *(const f32x4*)(p.sg_v_bias + g * 256 + 32 * w + 16 + 4 * lh), *(const f32x4*)(p.sg_v_bias + g * 256 + 32 * w + 24 + 4 * lh) };
#pragma unroll
        for (int tt = 0; tt < 4; ++tt) {
            const int t = 32 * tt + r; const size_t row = base + t;
            u32x2 uu[4];
#pragma unroll
            for (int g4 = 0; g4 < 4; ++g4) uu[g4] = *(const u32x2*)(Z + row * 4096 + g * 256 + 32 * w + 8 * g4 + 4 * lh);
            const float bp = p.sg_b_pos[g * 128 + t], at = At[t], bt = Bt[t];
            f32x16 acc = zero16();
#pragma unroll
            for (int ks = 0; ks < 8; ++ks) if (ks <= 2 * tt + 1) { const bf16x8 bw = *(const LAS bf16x8*)(Wp + (32 * tt + r) * 272 + (16 * ks + 8 * lh) * 2); acc = MFMA32(af[ks], bw, acc); }
#pragma unroll
            for (int g4 = 0; g4 < 4; ++g4) {
                const float m0 = gam[g4].x * (acc[4 * g4] - at) + bet[g4].x * bt + bp, m1 = gam[g4].y * (acc[4 * g4 + 1] - at) + bet[g4].y * bt + bp;
                const float m2 = gam[g4].z * (acc[4 * g4 + 2] - at) + bet[g4].z * bt + bp, m3 = gam[g4].w * (acc[4 * g4 + 3] - at) + bet[g4].w * bt + bp;
                u32x2 o; o.x = pk2(bflo(uu[g4].x) * m0, bfhi(uu[g4].x) * m1); o.y = pk2(bflo(uu[g4].y) * m2, bfhi(uu[g4].y) * m3);
                *(u32x2*)(Y + row * DM + g * 256 + 32 * w + 8 * g4 + 4 * lh) = o; }
        }
    }
}
constexpr size_t WS_BAR = 9 * MiB;
constexpr size_t WS_QCNT = WS_BAR + 32768;
constexpr size_t WS_ROWSS = WS_BAR + 65536, WS_PCNT = WS_BAR + 524288, WS_ZERO_BYTES = 1048576;
constexpr int LDS_BARST = 139264;
#define XB_TMO      128
#define XB_XCNT(j)  (256  + 64 * (j))
#define XB_XSUB(j)  (1280 + 64 * (j))
#define XB_XGEN(j)  (2304 + 64 * (j))
#define XB_TOP      3328
#define XB_TOPGEN   3392
#define XCD_BAR_WORDS 3456
#define XB_SPIN_CAP (1u << 18)

__device__ __forceinline__ unsigned xb_ld(unsigned* p)              { return __hip_atomic_load(p, __ATOMIC_RELAXED, __HIP_MEMORY_SCOPE_AGENT); }
__device__ __forceinline__ unsigned xb_add(unsigned* p, unsigned v) { return __hip_atomic_fetch_add(p, v, __ATOMIC_RELAXED, __HIP_MEMORY_SCOPE_AGENT); }
__device__ __forceinline__ unsigned xb_xcc_id() { return (unsigned)__builtin_amdgcn_s_getreg((3 << 11) | 20) & 0xFu; }
#define XB_SPIN(cond, bar) do { unsigned _sp = 0; while (cond) { __builtin_amdgcn_s_sleep(1); \
    if ((++_sp & 255u) == 0u) { if (xb_ld(&(bar)[XB_TMO])) break; if (_sp > XB_SPIN_CAP) { atomicAdd(&(bar)[XB_TMO], 1u); break; } } } } while (0)

struct XcdBarrier {
    unsigned* bar; unsigned x;
    volatile LAS unsigned* st;
};

__device__ __forceinline__ XcdBarrier xcd_barrier_post(unsigned* bar, volatile LAS unsigned* st) {
    XcdBarrier b; b.bar = bar; b.x = xb_xcc_id(); b.st = st;
    if (threadIdx.x == 0) (void)xb_add(&bar[XB_XCNT(b.x)], 1u);
    return b;
}
__device__ __forceinline__ void xcd_barrier_complete(unsigned* bar, unsigned x, unsigned& nloc, unsigned& nx) {
    const unsigned G = gridDim.x * gridDim.y * gridDim.z;
    unsigned sum, cnt, mine, sp = 0u;
    for (;;) {
        sum = 0u; cnt = 0u; mine = 0u;
#pragma unroll
        for (unsigned j = 0; j < 16; ++j) { const unsigned c = xb_ld(&bar[XB_XCNT(j)]); sum += c; cnt += (c > 0u) ? 1u : 0u; mine = (j == x) ? c : mine; }
        if (sum == G) break;
        __builtin_amdgcn_s_sleep(1);
        if ((++sp & 255u) == 0u) { if (xb_ld(&bar[XB_TMO])) break; if (sp > XB_SPIN_CAP) { atomicAdd(&bar[XB_TMO], 1u); break; } }
    }
    nloc = mine > 0u ? mine : 1u; nx = cnt > 0u ? cnt : 1u;
}

__device__ __forceinline__ void xcd_barrier(const XcdBarrier& b) {
    asm volatile("s_waitcnt vmcnt(0)" ::: "memory");
    __syncthreads();
    if (threadIdx.x == 0) {
        unsigned* bar = b.bar;
        __builtin_amdgcn_s_waitcnt(0);
        unsigned nloc = b.st[0], nx = b.st[1];
        if (nloc == 0u) { xcd_barrier_complete(bar, b.x, nloc, nx); b.st[0] = nloc; b.st[1] = nx; }
        const unsigned old = xb_add(&bar[XB_XSUB(b.x)], 1u);
        const unsigned gen = old / nloc;
        if (old + 1u == (gen + 1u) * nloc) {
            __builtin_amdgcn_fence(__ATOMIC_RELEASE, "agent");
            asm volatile("s_waitcnt vmcnt(0)" ::: "memory");
            const unsigned og = xb_add(&bar[XB_TOP], 1u);
            const unsigned tg = og / nx;
            if (og + 1u == (tg + 1u) * nx) xb_add(&bar[XB_TOPGEN], 1u);
            else XB_SPIN(xb_ld(&bar[XB_TOPGEN]) == tg, bar);
            __builtin_amdgcn_fence(__ATOMIC_ACQUIRE, "agent");
            xb_add(&bar[XB_XGEN(b.x)], 1u);
            asm volatile("s_waitcnt vmcnt(0)" ::: "memory");
        } else {
            XB_SPIN(xb_ld(&bar[XB_XGEN(b.x)]) == gen, bar);
            __builtin_amdgcn_fence(__ATOMIC_ACQUIRE, "agent");
            asm volatile("s_waitcnt vmcnt(0)" ::: "memory");
        }
    }
    __syncthreads();
}


template <class Epi, class Sched = pg8::StaticOrder> DI void run_gemm(LAS unsigned char* lds, const bf16_t* A, const bf16_t* Bt, int N, int K, const Epi& E) {
    pg8::Gemm g{A, Bt, T_TOK, N, K}; Sched S; S.init(T_TOK, N, (int)gridDim.x, (int)blockIdx.x);
    pg8::gemm_phase<Epi, Sched, true, true>((PG8_LAS unsigned char*)lds, g, S, E);
}

#define PHASE_HEAD() const int tid = opaque_tid(), lane = tid & 63, wave = __builtin_amdgcn_readfirstlane(tid >> 6); const int gw = blockIdx.x * 8 + wave, ngw = gridDim.x * 8; (void)lane; (void)gw; (void)ngw;
#define WSP(T, off) ((T*)(p.ws + (off)))
typedef const __attribute__((address_space(4))) unsigned long long* KAP;
DI P load_args() {
    KAP kp = (KAP)__builtin_amdgcn_kernarg_segment_ptr();
    asm volatile("" : "+s"(kp));
    P p;
#define KARGF(i) ((const float*)(const __attribute__((address_space(1))) float*)kp[i])
    p.x = KARGF(0); p.c = KARGF(1); p.ada_w = KARGF(2); p.ada_b = KARGF(3); p.mix_norm = KARGF(4); p.ffn_norm = KARGF(5);
    p.par_w_in = KARGF(6); p.par_w_out = KARGF(7); p.lb_logits = KARGF(8); p.hg_out_norm = KARGF(9); p.sg_w_in = KARGF(10);
    p.sg_v_gain = KARGF(11); p.sg_v_bias = KARGF(12); p.sg_w_pos = KARGF(13); p.sg_b_pos = KARGF(14); p.sg_w_out = KARGF(15);
    p.ffn_up = KARGF(16); p.conv_w = KARGF(17); p.conv_b = KARGF(18); p.ffn_down = KARGF(19); p.final_norm = KARGF(20);
    p.out = (float*)(__attribute__((address_space(1))) float*)kp[21]; p.ws = (unsigned char*)(__attribute__((address_space(1))) unsigned char*)kp[22];
#undef KARGF
    return p;
}
#define LDSP ((LAS unsigned char*)lds_raw)
#ifndef REP_A
#define REP_A 1
#endif
#ifndef REP_B
#define REP_B 1
#endif
#ifndef REP_C
#define REP_C 1
#endif
#ifndef REP_S
#define REP_S 1
#endif
#define GSYNC() do { for (int rs_ = 0; rs_ < REP_S; ++rs_) { const P pb_ = load_args(); XcdBarrier xb_; xb_.bar = (unsigned*)(pb_.ws + WS_BAR); xb_.x = xb_xcc_id(); xb_.st = (volatile LAS unsigned*)(LDSP + LDS_BARST); xcd_barrier(xb_); } } while (0)
#define RA for (int ra_ = 0; ra_ < REP_A; ++ra_)
#define RB for (int rb_ = 0; rb_ < REP_B; ++rb_)
#define RC for (int rc_ = 0; rc_ < REP_C; ++rc_)

#define FUSED_NORM (gridDim.x == 256)
#define RNORM(id) WSP(float, WS_ROWSS) + (id) * 16384, WSP(unsigned, WS_PCNT) + (id) * 4096
template <int LAYER> DI void ffn_block(unsigned char* lds_raw, cg::grid_group& grid) {
    if (!FUSED_NORM) {
        RA { const P p = load_args(); PHASE_HEAD(); const float* modl = WSP(const float, WS_MOD) + (size_t)LAYER * 4 * MODW;
          norm_rows(p.out, p.ffn_norm + LAYER * DM, modl + 3 * DM, modl + 4 * DM, WSP(bf16_t, WS_HY), gw, ngw, lane); }
        GSYNC();
    }
    RC { const P p = load_args(); pg8::EpiConv E{WSP(bf16_t, WS_U), WSP(float, WS_UT), p.conv_w + (size_t)LAYER * 3 * FF2, p.conv_b + (size_t)LAYER * FF2, (PG8_LAS unsigned char*)(LDSP + 131072)};
         run_gemm(LDSP, WSP(const bf16_t, WS_HY), WSP(const bf16_t, WS_WU), FF2, DM, E); }
    GSYNC();
    { const P p = load_args(); conv_fixup(WSP(const float, WS_UT), p.conv_w + (size_t)LAYER * 3 * FF2, p.conv_b + (size_t)LAYER * FF2, WSP(bf16_t, WS_U)); }
    GSYNC();
    { const P p = load_args(); const float* modl = WSP(const float, WS_MOD) + (size_t)LAYER * 4 * MODW;
      if (FUSED_NORM) {
          const float* mod1 = WSP(const float, WS_MOD) + 4 * MODW;
          if (LAYER == 0) { pg8::EpiResidNorm<1, 1> E{WSP(bf16_t, WS_XB), WSP(bf16_t, WS_XB), modl + 5 * DM, p.mix_norm + DM, mod1 + DM, mod1, WSP(bf16_t, WS_HY), RNORM(1)}; run_gemm<pg8::EpiResidNorm<1, 1>, pg8::PanelOrder>(LDSP, WSP(const bf16_t, WS_U), WSP(const bf16_t, WS_WD), DM, FF, E); }
          else { pg8::EpiResidNorm<1, 2> E{WSP(bf16_t, WS_XB), p.out, modl + 5 * DM, p.final_norm, nullptr, nullptr, WSP(bf16_t, WS_HY), RNORM(3)}; run_gemm<pg8::EpiResidNorm<1, 2>, pg8::PanelOrder>(LDSP, WSP(const bf16_t, WS_U), WSP(const bf16_t, WS_WD), DM, FF, E); }
      } else { pg8::EpiResid E{p.out, p.out, modl + 5 * DM}; run_gemm(LDSP, WSP(const bf16_t, WS_U), WSP(const bf16_t, WS_WD), DM, FF, E); } }
    GSYNC();
}

__global__ void __launch_bounds__(512, 2) fwd_megakernel(P p_arg) {
    extern __shared__ __attribute__((aligned(16))) unsigned char lds_raw[];
    cg::grid_group grid = cg::this_grid();
    { if (threadIdx.x < 2) ((volatile LAS unsigned*)(LDSP + LDS_BARST))[threadIdx.x] = 0u;
      __syncthreads();
      const P pb_ = load_args(); if (pb_.ws == nullptr) grid.sync();
      (void)xcd_barrier_post((unsigned*)(pb_.ws + WS_BAR), (volatile LAS unsigned*)(LDSP + LDS_BARST)); }
    RA { const P p = load_args(); PHASE_HEAD(); convert_weights(p, 0, LDSP, gw, ngw, wave, lane); ada_partials(p, LDSP); }
    GSYNC();
    RA { const P p = load_args(); mod_reduce(p); }
    GSYNC();
    RA { const P p = load_args(); PHASE_HEAD(); const float* mod0 = WSP(const float, WS_MOD); norm_rows(p.x, p.mix_norm, mod0, mod0 + DM, WSP(bf16_t, WS_HY), gw, ngw, lane); }
    GSYNC();
    RC { const P p = load_args(); pg8::EpiBf16 E{WSP(bf16_t, WS_BIG), PIN, 0}; run_gemm(LDSP, WSP(const bf16_t, WS_HY), WSP(const bf16_t, WS_WA), PIN, DM, E); }
    GSYNC();
    RB { const P p = load_args(); v_transpose(WSP(const bf16_t, WS_BIG), WSP(bf16_t, WS_VT), LDSP); }
#ifdef REP_HGA
    for (int rq_ = 0; rq_ < 2; ++rq_)
#endif
    RB { const P p = load_args(); hg_phase_a(p, WSP(const bf16_t, WS_BIG), WSP(float, WS_UT), WSP(float, WS_DEC), LDSP); }
    GSYNC();
    RB { const P p = load_args(); hg_phase_b(WSP(const float, WS_UT), WSP(const float, WS_DEC), WSP(bf16_t, WS_ST)); }
    GSYNC();
#ifdef REP_ATT
    for (int rq_ = 0; rq_ < REP_ATT; ++rq_)
#endif
    RB { const P p = load_args(); attn_phase(WSP(const bf16_t, WS_BIG), WSP(const bf16_t, WS_VT), WSP(bf16_t, WS_HY), LDSP, WSP(unsigned, WS_QCNT)); }
#ifdef REP_HGC
    for (int rq_ = 0; rq_ < 2; ++rq_)
#endif
    RB { const P p = load_args(); hg_phase_c(p, WSP(const bf16_t, WS_BIG), WSP(const bf16_t, WS_ST), WSP(bf16_t, WS_HY), LDSP, WSP(unsigned, WS_QCNT) + 128); }
    GSYNC();
    { const P p = load_args(); const float* mod0 = WSP(const float, WS_MOD);
      if (FUSED_NORM) { pg8::EpiResidNorm<0, 1> E{p.x, WSP(bf16_t, WS_XB), mod0 + 2 * DM, p.ffn_norm, mod0 + 4 * DM, mod0 + 3 * DM, WSP(bf16_t, WS_HY), RNORM(0)}; run_gemm<pg8::EpiResidNorm<0, 1>, pg8::PanelOrder>(LDSP, WSP(const bf16_t, WS_HY), WSP(const bf16_t, WS_WO), DM, DM, E); }
      else { pg8::EpiResid E{p.x, p.out, mod0 + 2 * DM}; run_gemm(LDSP, WSP(const bf16_t, WS_HY), WSP(const bf16_t, WS_WO), DM, DM, E); } }
    GSYNC();
    ffn_block<0>(lds_raw, grid);
    RA { const P p = load_args(); PHASE_HEAD(); const float* mod1 = WSP(const float, WS_MOD) + 4 * MODW;
      if (!FUSED_NORM) norm_rows(p.out, p.mix_norm + DM, mod1, mod1 + DM, WSP(bf16_t, WS_HY), gw, ngw, lane);
      convert_weights(p, 1, LDSP, gw, ngw, wave, lane); }
    GSYNC();
    RC { const P p = load_args(); pg8::EpiBf16 E{WSP(bf16_t, WS_Z), 4096, 1}; run_gemm(LDSP, WSP(const bf16_t, WS_HY), WSP(const bf16_t, WS_WA), 4096, DM, E); }
    GSYNC();
    RB { const P p = load_args(); PHASE_HEAD(); sg_stats(WSP(const bf16_t, WS_Z), WSP(float, WS_STATS), gw, ngw, lane); }
    GSYNC();
#ifdef REP_SG
    for (int rq_ = 0; rq_ < 2; ++rq_)
#endif
    RB { const P p = load_args(); sg_mix(p, WSP(const bf16_t, WS_Z), WSP(const float, WS_STATS), WSP(bf16_t, WS_HY), LDSP); }
    GSYNC();
    { const P p = load_args(); const float* mod1 = WSP(const float, WS_MOD) + 4 * MODW;
      if (FUSED_NORM) { pg8::EpiResidNorm<1, 1> E{WSP(bf16_t, WS_XB), WSP(bf16_t, WS_XB), mod1 + 2 * DM, p.ffn_norm + DM, mod1 + 4 * DM, mod1 + 3 * DM, WSP(bf16_t, WS_HY), RNORM(2)}; run_gemm<pg8::EpiResidNorm<1, 1>, pg8::PanelOrder>(LDSP, WSP(const bf16_t, WS_HY), WSP(const bf16_t, WS_WO), DM, DM, E); }
      else { pg8::EpiResid E{p.out, p.out, mod1 + 2 * DM}; run_gemm(LDSP, WSP(const bf16_t, WS_HY), WSP(const bf16_t, WS_WO), DM, DM, E); } }
    GSYNC();
    ffn_block<1>(lds_raw, grid);
    if (!FUSED_NORM) { const P p = load_args(); PHASE_HEAD(); final_norm_rows(p.out, p.final_norm, gw, ngw, lane); }
}

extern "C" void kernel_launch(void* const* d_in, const int* in_sizes, int n_in, void* d_out, int out_size, void* d_ws, size_t ws_size, hipStream_t stream) {
    static int grid = 0;
    if (grid == 0) {
        if (n_in != 21 || out_size != T_TOK * DM || ws_size < WS_END) { fprintf(stderr, "kernel_launch: unexpected shapes: n_in %d out %d ws %zu (need %zu)\n", n_in, out_size, ws_size, (size_t)WS_END); grid = -1; return; }
        int dev = 0, cus = 0, per_cu = 0;
        hipGetDevice(&dev); hipDeviceGetAttribute(&cus, hipDeviceAttributeMultiprocessorCount, dev);
        if (hipFuncSetAttribute((const void*)fwd_megakernel, hipFuncAttributeMaxDynamicSharedMemorySize, LDS_BYTES) != hipSuccess) { fprintf(stderr, "kernel_launch: hipFuncSetAttribute failed\n"); grid = -1; return; }
        if (hipOccupancyMaxActiveBlocksPerMultiprocessor(&per_cu, (const void*)fwd_megakernel, 512, LDS_BYTES) != hipSuccess || per_cu < 1) { fprintf(stderr, "kernel_launch: occupancy query says %d\n", per_cu); per_cu = 1; }
        (void)hipGetLastError();
        grid = cus * 1;
    }
    if (grid < 0) return;
    if (hipMemsetAsync((char*)d_ws + WS_BAR, 0, WS_ZERO_BYTES, stream) != hipSuccess) { fprintf(stderr, "kernel_launch: memset failed\n"); return; }
    P p{};
    const float** f = (const float**)&p;
    for (int i = 0; i < 21; ++i) f[i] = (const float*)d_in[i];
    p.out = (float*)d_out; p.ws = (unsigned char*)d_ws;
    void* args[] = {&p};
    hipError_t e = hipLaunchCooperativeKernel((const void*)fwd_megakernel, dim3(grid), dim3(512), args, LDS_BYTES, stream);
    if (e != hipSuccess) fprintf(stderr, "cooperative launch failed: %s (grid %d)\n", hipGetErrorString(e), grid);
}
```

```cpp
#include <hip/hip_runtime.h>
#include <hip/hip_cooperative_groups.h>
#include <cstdio>
#include <cstdint>
namespace cg = cooperative_groups;
__device__ __forceinline__ int opaque_tid() { int t = threadIdx.x; asm volatile("" : "+v"(t)); return t; }
namespace pg8 {
#define PG8_LAS __attribute__((address_space(3)))
typedef unsigned short bf16_t;
typedef short bf16x8 __attribute__((ext_vector_type(8)));
typedef float f32x4 __attribute__((ext_vector_type(4)));
typedef unsigned u32x4 __attribute__((ext_vector_type(4)));
constexpr int BM = 256, BK = 64, HALF = 128, HTB = HALF * BK * 2  , STAGE_BYTES = 8 * HTB, NXCD = 8, WGM = 8;

__host__ __device__ __forceinline__ int lds_byte(int r, int c) { const int st = (r >> 4) * 2 + (c >> 5), rr = r & 15, cc = c & 31, ob = rr * 64 + cc * 2; return st * 1024 + (ob ^ (((ob >> 9) & 1) << 5)); }
__host__ __device__ __forceinline__ void stage_rc(int b, int& R, int& C) { const int st = b / 1024, sb = b % 1024, swz = sb ^ (((sb >> 9) & 1) << 5); R = (st >> 1) * 16 + swz / 64; C = (st & 1) * 32 + (swz % 64) / 2; }
__host__ __device__ __forceinline__ int perm32(int rho) { const int n = rho >> 4, i = rho & 15; return 8 * (i >> 2) + 4 * n + (i & 3); }

struct Unit { int pm, pn; };
struct Gemm { const bf16_t* A; const bf16_t* Bt; int M, N, K; };

struct StaticOrder {
    int nM, nN, nwg, G, c;
    __host__ __device__ void init(int M, int N, int G_, int c_) { nM = M / BM; nN = N / BM; nwg = nM * nN; G = G_; c = c_; }
    __host__ __device__ bool next(int i, Unit& u) const {
        const long L = (long)i * G + c; if (L >= nwg) return false;
        int wgid = (int)L; { const int q = nwg / NXCD, r = nwg % NXCD, xcd = wgid % NXCD, off = wgid / NXCD; wgid = (xcd < r ? xcd * (q + 1) : r * (q + 1) + (xcd - r) * q) + off; }
        const int nig = WGM * nN, gid = wgid / nig, fm = gid * WGM, gsz = (nM - fm) < WGM ? (nM - fm) : WGM;
        u.pm = fm + ((wgid % nig) % gsz); u.pn = (wgid % nig) / gsz; return true;
    }
    __device__ __forceinline__ void a_ready(const Unit&) const {}
    __device__ __forceinline__ void done(const Unit&) const {}
};
struct PanelOrder {
    int c, nr;
    __host__ __device__ void init(int M, int, int, int c_) { c = c_; nr = M / (32 * BM); }
    __host__ __device__ bool next(int i, Unit& u) const { if (i >= nr) return false; const int xcd = c & 7, idx = c >> 3; u.pm = 32 * i + 4 * xcd + (idx >> 3); u.pn = idx & 7; return true; }
    __device__ __forceinline__ void a_ready(const Unit&) const {}
    __device__ __forceinline__ void done(const Unit&) const {}
};

typedef float f32x2 __attribute__((ext_vector_type(2)));
typedef __bf16 bf16v2 __attribute__((ext_vector_type(2)));
__device__ __forceinline__ unsigned cvt_pk_bf16(float lo, float hi) { f32x2 v = {lo, hi}; return __builtin_bit_cast(unsigned, __builtin_convertvector(v, bf16v2)); }
__device__ __forceinline__ f32x2 gelu_pk(f32x2 v) {
    const f32x2 av = __builtin_elementwise_abs(v), d = av * 0.2316418882f + 1.0f;
    f32x2 t; t.x = __builtin_amdgcn_rcpf(d.x); t.y = __builtin_amdgcn_rcpf(d.y);
    f32x2 q = t * 0.5307027145f + (-0.7265760135f); q = q * t + 0.7107068705f; q = q * t + (-0.142248368f); q = q * t + 0.127414796f; q = q * t;
    const f32x2 s = (v * v) * (-0.72134752044f);
    f32x2 e; e.x = __builtin_amdgcn_exp2f(s.x); e.y = __builtin_amdgcn_exp2f(s.y);
    const f32x2 m = v * (q * e), r = v - m;
    f32x2 o; o.x = v.x < 0.f ? m.x : r.x; o.y = v.y < 0.f ? m.y : r.y; return o;
}
struct EpiBf16 {
    static constexpr bool PERM = true, AFTER_DRAIN = false;
    bf16_t* O; int ldc; int act;
    __device__ __forceinline__ void operator()(const f32x4 (&acc)[2][2][4][2], const Unit& u, int wr, int wc, int fr, int fq) const {
        const int row0 = u.pm * BM + wr * 64 + fr; const int col0 = u.pn * BM + wc * 32 + 8 * fq;
#pragma unroll
        for (int ai = 0; ai < 2; ++ai)
#pragma unroll
            for (int m = 0; m < 4; ++m) { bf16_t* rowp = O + (size_t)(row0 + ai * HALF + m * 16) * ldc + col0;
#pragma unroll
                for (int bj = 0; bj < 2; ++bj) { f32x4 v0 = acc[ai][bj][m][0], v1 = acc[ai][bj][m][1];
                    if (act) { f32x2 a = gelu_pk((f32x2){v0[0], v0[1]}), b = gelu_pk((f32x2){v0[2], v0[3]}), c = gelu_pk((f32x2){v1[0], v1[1]}), d = gelu_pk((f32x2){v1[2], v1[3]});
                        v0 = (f32x4){a.x, a.y, b.x, b.y}; v1 = (f32x4){c.x, c.y, d.x, d.y}; }
                    u32x4 w; w.x = cvt_pk_bf16(v0[0], v0[1]); w.y = cvt_pk_bf16(v0[2], v0[3]); w.z = cvt_pk_bf16(v1[0], v1[1]); w.w = cvt_pk_bf16(v1[2], v1[3]);
                    *(u32x4*)(rowp + bj * HALF) = w; } }
    }
};
struct EpiResid {
    static constexpr bool PERM = false, AFTER_DRAIN = false;
    const float* Xin; float* Xout; const float* gate;
    __device__ __forceinline__ void operator()(const f32x4 (&acc)[2][2][4][2], const Unit& u, int wr, int wc, int fr, int fq) const {
        const int row0 = u.pm * BM + wr * 64 + fr, col0 = u.pn * BM + wc * 32 + 4 * fq; const int b = u.pm >> 4;
        f32x4 gv[2][2];
#pragma unroll
        for (int bj = 0; bj < 2; ++bj)
#pragma unroll
            for (int n = 0; n < 2; ++n) gv[bj][n] = *(const f32x4*)(gate + (size_t)b * 12288 + col0 + bj * HALF + n * 16);
        f32x4 xa[2][2], xb[2][2];
#define RES_LD(dst, g) { const size_t off_ = (size_t)(row0 + ((g) >> 2) * HALF + ((g) & 3) * 16) * 2048 + col0; \
            dst[0][0] = *(const f32x4*)(Xin + off_); dst[0][1] = *(const f32x4*)(Xin + off_ + 16); dst[1][0] = *(const f32x4*)(Xin + off_ + HALF); dst[1][1] = *(const f32x4*)(Xin + off_ + HALF + 16); }
#define RES_ST(src, g) { const size_t off_ = (size_t)(row0 + ((g) >> 2) * HALF + ((g) & 3) * 16) * 2048 + col0; \
            *(f32x4*)(Xout + off_) = src[0][0] + gv[0][0] * acc[(g) >> 2][0][(g) & 3][0]; *(f32x4*)(Xout + off_ + 16) = src[0][1] + gv[0][1] * acc[(g) >> 2][0][(g) & 3][1]; \
            *(f32x4*)(Xout + off_ + HALF) = src[1][0] + gv[1][0] * acc[(g) >> 2][1][(g) & 3][0]; *(f32x4*)(Xout + off_ + HALF + 16) = src[1][1] + gv[1][1] * acc[(g) >> 2][1][(g) & 3][1]; }
        RES_LD(xa, 0)
#pragma unroll
        for (int g = 0; g < 8; g += 2) {
            RES_LD(xb, g + 1)
            asm volatile("" ::: "memory");
            RES_ST(xa, g)
            asm volatile("" ::: "memory");
            if (g + 2 < 8) RES_LD(xa, g + 2)
            asm volatile("" ::: "memory");
            RES_ST(xb, g + 1)
            asm volatile("" ::: "memory");
        }
#undef RES_LD
#undef RES_ST
    }
};

typedef unsigned u32x2 __attribute__((ext_vector_type(2)));
template <int XIN, int XST> struct EpiResidNorm {
    static constexpr bool PERM = false, AFTER_DRAIN = false;
    const void* Xin; void* Xout; const float* gate; const float* gain; const float* sc; const float* sh; bf16_t* H; float* rowss; unsigned* cnt;
    __device__ __forceinline__ void operator()(f32x4 (&acc)[2][2][4][2], const Unit& u, int wr, int wc, int fr, int fq) const {
        const int row0 = u.pm * BM + wr * 64 + fr, col0 = u.pn * BM + wc * 32 + 4 * fq; const int b = u.pm >> 4;
        const bool fin = (sc == nullptr);
        f32x4 gv[2][2];
#pragma unroll
        for (int bj = 0; bj < 2; ++bj)
#pragma unroll
            for (int n = 0; n < 2; ++n) gv[bj][n] = *(const f32x4*)(gate + (size_t)b * 12288 + col0 + bj * HALF + n * 16);
        f32x4 xa[2][2], xb[2][2];
#define RES_LD1(dst, o2) { if (XIN == 0) dst = *(const f32x4*)((const float*)Xin + (o2)); else { const u32x2 w_ = *(const u32x2*)((const bf16_t*)Xin + (o2)); \
                dst = (f32x4){__uint_as_float(w_.x << 16), __uint_as_float(w_.x & 0xffff0000u), __uint_as_float(w_.y << 16), __uint_as_float(w_.y & 0xffff0000u)}; } }
#define RES_LD(dst, g) { const size_t off_ = (size_t)(row0 + ((g) >> 2) * HALF + ((g) & 3) * 16) * 2048 + col0; \
            RES_LD1(dst[0][0], off_) RES_LD1(dst[0][1], off_ + 16) RES_LD1(dst[1][0], off_ + HALF) RES_LD1(dst[1][1], off_ + HALF + 16) }
#define RES_ST(src, g) { const size_t off_ = (size_t)(row0 + ((g) >> 2) * HALF + ((g) & 3) * 16) * 2048 + col0; float ss_ = 0.f; \
            _Pragma("unroll") for (int bj_ = 0; bj_ < 2; ++bj_) _Pragma("unroll") for (int n_ = 0; n_ < 2; ++n_) { \
                const f32x4 x_ = src[bj_][n_] + gv[bj_][n_] * acc[(g) >> 2][bj_][(g) & 3][n_]; acc[(g) >> 2][bj_][(g) & 3][n_] = x_; \
                ss_ += (x_[0] * x_[0] + x_[1] * x_[1]) + (x_[2] * x_[2] + x_[3] * x_[3]); \
                if (XST == 0) *(f32x4*)((float*)Xout + off_ + bj_ * HALF + n_ * 16) = x_; \
                if (XST == 1) { u32x2 w_; w_.x = cvt_pk_bf16(x_[0], x_[1]); w_.y = cvt_pk_bf16(x_[2], x_[3]); *(u32x2*)((bf16_t*)Xout + off_ + bj_ * HALF + n_ * 16) = w_; } } \
            ss_ += __shfl_xor(ss_, 16); ss_ += __shfl_xor(ss_, 32); \
            if (fq == 0) (void)__hip_atomic_fetch_add(rowss + row0 + ((g) >> 2) * HALF + ((g) & 3) * 16, ss_, __ATOMIC_RELAXED, __HIP_MEMORY_SCOPE_AGENT); }
        RES_LD(xa, 0)
#pragma unroll
        for (int g = 0; g < 8; g += 2) {
            RES_LD(xb, g + 1)
            asm volatile("" ::: "memory");
            RES_ST(xa, g)
            asm volatile("" ::: "memory");
            if (g + 2 < 8) RES_LD(xa, g + 2)
            asm volatile("" ::: "memory");
            RES_ST(xb, g + 1)
            asm volatile("" ::: "memory");
        }
#undef RES_LD
#undef RES_LD1
#undef RES_ST
        asm volatile("s_waitcnt vmcnt(0)" ::: "memory");
        unsigned* c = cnt + 64 * u.pm;
        if (fq * 16 + fr == 0) (void)__hip_atomic_fetch_add(c, 1u, __ATOMIC_RELAXED, __HIP_MEMORY_SCOPE_AGENT);
        { unsigned sp = 0;
          while ((unsigned)__builtin_amdgcn_readfirstlane((int)__hip_atomic_load(c, __ATOMIC_RELAXED, __HIP_MEMORY_SCOPE_AGENT)) < 64u) { __builtin_amdgcn_s_sleep(1); if (++sp > (1u << 22)) break; } }
        f32x4 gg[2][2], hh[2][2];
#pragma unroll
        for (int bj = 0; bj < 2; ++bj)
#pragma unroll
            for (int n = 0; n < 2; ++n) { const int cc = col0 + bj * HALF + n * 16; const f32x4 ga = *(const f32x4*)(gain + cc);
                if (fin) { gg[bj][n] = ga; hh[bj][n] = (f32x4){0.f, 0.f, 0.f, 0.f}; }
                else { gg[bj][n] = ga * (*(const f32x4*)(sc + (size_t)b * 12288 + cc) + 1.0f); hh[bj][n] = *(const f32x4*)(sh + (size_t)b * 12288 + cc); } }
        float rsv[8];
        { const float* rp = rowss + row0;
          asm volatile("global_load_dword %0, %8, off sc1\n\tglobal_load_dword %1, %8, off offset:64 sc1\n\tglobal_load_dword %2, %8, off offset:128 sc1\n\tglobal_load_dword %3, %8, off offset:192 sc1\n\t"
                       "global_load_dword %4, %8, off offset:512 sc1\n\tglobal_load_dword %5, %8, off offset:576 sc1\n\tglobal_load_dword %6, %8, off offset:640 sc1\n\tglobal_load_dword %7, %8, off offset:704 sc1\n\t"
                       "s_waitcnt vmcnt(0)"
                       : "=&v"(rsv[0]), "=&v"(rsv[1]), "=&v"(rsv[2]), "=&v"(rsv[3]), "=&v"(rsv[4]), "=&v"(rsv[5]), "=&v"(rsv[6]), "=&v"(rsv[7]) : "v"(rp) : "memory"); }
#pragma unroll
        for (int g = 0; g < 8; ++g) {
            const int row = row0 + (g >> 2) * HALF + (g & 3) * 16;
            const float rstd = __builtin_amdgcn_rsqf(rsv[g] * (1.0f / 2048.0f) + 1e-6f);
#pragma unroll
            for (int bj = 0; bj < 2; ++bj)
#pragma unroll
                for (int n = 0; n < 2; ++n) { const f32x4 o = acc[g >> 2][bj][g & 3][n] * rstd * gg[bj][n] + hh[bj][n]; const size_t off = (size_t)row * 2048 + col0 + bj * HALF + n * 16;
                    if (fin) *(f32x4*)((float*)Xout + off) = o;
                    else { u32x2 w; w.x = cvt_pk_bf16(o[0], o[1]); w.y = cvt_pk_bf16(o[2], o[3]); *(u32x2*)(H + off) = w; } }
        }
    }
};

__device__ __forceinline__ float dpp_ror1(float v) { const int x = __builtin_bit_cast(int, v); return __builtin_bit_cast(float, __builtin_amdgcn_update_dpp(x, x, 0x121, 0xf, 0xf, false)); }
__device__ __forceinline__ float dpp_ror2(float v) { const int x = __builtin_bit_cast(int, v); return __builtin_bit_cast(float, __builtin_amdgcn_update_dpp(x, x, 0x122, 0xf, 0xf, false)); }
__device__ __forceinline__ float dpp_shr1(float old, float v) { return __builtin_bit_cast(float, __builtin_amdgcn_update_dpp(__builtin_bit_cast(int, old), __builtin_bit_cast(int, v), 0x111, 0xf, 0xf, false)); }
__device__ __forceinline__ float dpp_shr2(float old, float v) { return __builtin_bit_cast(float, __builtin_amdgcn_update_dpp(__builtin_bit_cast(int, old), __builtin_bit_cast(int, v), 0x112, 0xf, 0xf, false)); }
struct EpiConv {
    static constexpr bool PERM = false, AFTER_DRAIN = false;
    bf16_t* U; float* SB; const float* cw; const float* cb; PG8_LAS unsigned char* xb;
    __device__ __forceinline__ void operator()(const f32x4 (&acc)[2][2][4][2], const Unit& u, int wr, int wc, int fr, int fq) const {
        constexpr int FFc = 5632, FF2c = 11264;
        const int lane = fq * 16 + fr, l16 = fq * 16;
        const int row0 = u.pm * BM + wr * 64 + fr, jcol = u.pn * HALF + wc * 32 + 4 * fq;
        const f32x4 pwg0 = *(const f32x4*)(cw + jcol), pwg1 = *(const f32x4*)(cw + FF2c + jcol), pwg2 = *(const f32x4*)(cw + 2 * FF2c + jcol), pbg = *(const f32x4*)(cb + jcol);
        const f32x4 pwv0 = *(const f32x4*)(cw + FFc + jcol), pwv1 = *(const f32x4*)(cw + FF2c + FFc + jcol), pwv2 = *(const f32x4*)(cw + 2 * FF2c + FFc + jcol), pbv = *(const f32x4*)(cb + FFc + jcol);
#pragma unroll
        for (int ai = 0; ai < 2; ++ai) {
            if (fr >= 14) {
                PG8_LAS f32x4* dst = (PG8_LAS f32x4*)(xb + (((((ai * 2 + wr) * 4 + wc) * 2 + (fr - 14)) * 4 + fq) * 64));
                dst[0] = acc[ai][0][3][0]; dst[1] = acc[ai][0][3][1]; dst[2] = acc[ai][1][3][0]; dst[3] = acc[ai][1][3][1];
            }
        }
        { const int colb = u.pn * BM + wc * 32 + 4 * fq;
          if (wr == 0 && fr < 2) { float* sb = SB + ((size_t)(u.pm * 4 + fr)) * FF2c + colb;
              *(f32x4*)(sb) = acc[0][0][0][0]; *(f32x4*)(sb + 16) = acc[0][0][0][1]; *(f32x4*)(sb + HALF) = acc[0][1][0][0]; *(f32x4*)(sb + HALF + 16) = acc[0][1][0][1]; }
          if (wr == 1 && fr >= 14) { float* sb = SB + ((size_t)(u.pm * 4 + 2 + (fr - 14))) * FF2c + colb;
              *(f32x4*)(sb) = acc[1][0][3][0]; *(f32x4*)(sb + 16) = acc[1][0][3][1]; *(f32x4*)(sb + HALF) = acc[1][1][3][0]; *(f32x4*)(sb + HALF + 16) = acc[1][1][3][1]; } }
        asm volatile("s_waitcnt lgkmcnt(0)" ::: "memory"); __builtin_amdgcn_s_barrier(); asm volatile("" ::: "memory");
#pragma unroll
        for (int n = 0; n < 2; ++n) {
            const int j = jcol + 16 * n;
            f32x4 wg0, wg1, wg2, bg, wv0, wv1, wv2, bv;
            if (n == 0) { wg0 = pwg0; wg1 = pwg1; wg2 = pwg2; bg = pbg; wv0 = pwv0; wv1 = pwv1; wv2 = pwv2; bv = pbv; }
            else { wg0 = *(const f32x4*)(cw + j); wg1 = *(const f32x4*)(cw + FF2c + j); wg2 = *(const f32x4*)(cw + 2 * FF2c + j); bg = *(const f32x4*)(cb + j);
                   wv0 = *(const f32x4*)(cw + FFc + j); wv1 = *(const f32x4*)(cw + FF2c + FFc + j); wv2 = *(const f32x4*)(cw + 2 * FF2c + FFc + j); bv = *(const f32x4*)(cb + FFc + j); }
#pragma unroll
            for (int ai = 0; ai < 2; ++ai) {
                const int sa = (wr == 1) ? ai : 0, sw = (wr == 1) ? 0 : 1;
                const PG8_LAS f32x4* x63 = (const PG8_LAS f32x4*)(xb + (((((sa * 2 + sw) * 4 + wc) * 2 + 1) * 4 + fq) * 64));
                const PG8_LAS f32x4* x62 = (const PG8_LAS f32x4*)(xb + (((((sa * 2 + sw) * 4 + wc) * 2 + 0) * 4 + fq) * 64));
                const f32x4 g63 = x63[n], v63 = x63[2 + n], g62 = x62[n], v62 = x62[2 + n];
#pragma unroll
                for (int m = 0; m < 4; ++m) {
                    const f32x4 cg = acc[ai][0][m][n], cv = acc[ai][1][m][n];
                    f32x4 qg1, qg2, qv1, qv2;
                    if (m == 0) { qg1 = g63; qv1 = v63; qg2 = (fr == 0) ? g62 : g63; qv2 = (fr == 0) ? v62 : v63; }
                    else {
                        const f32x4 og = acc[ai][0][m > 0 ? m - 1 : 0][n], ov = acc[ai][1][m > 0 ? m - 1 : 0][n];
#pragma unroll
                        for (int e = 0; e < 4; ++e) { qg1[e] = dpp_ror1(og[e]); qg2[e] = dpp_ror2(og[e]); qv1[e] = dpp_ror1(ov[e]); qv2[e] = dpp_ror2(ov[e]); }
                    }
                    u32x2 o;
                    float r[4];
#pragma unroll
                    for (int e = 0; e < 4; ++e) {
                        const float g1 = dpp_shr1(qg1[e], cg[e]), g2 = dpp_shr2(qg2[e], cg[e]), v1 = dpp_shr1(qv1[e], cv[e]), v2 = dpp_shr2(qv2[e], cv[e]);
                        const float ag = bg[e] + wg0[e] * g2 + wg1[e] * g1 + wg2[e] * cg[e];
                        const float av = bv[e] + wv0[e] * v2 + wv1[e] * v1 + wv2[e] * cv[e];
                        r[e] = ag * __builtin_amdgcn_rcpf(1.f + __expf(-ag)) * av;
                    }
                    o.x = cvt_pk_bf16(r[0], r[1]); o.y = cvt_pk_bf16(r[2], r[3]);
                    const bool first2 = (ai == 0 && m == 0) && (wr == 0) && (fr < 2);
                    if (!first2) *(u32x2*)(U + (size_t)(row0 + ai * HALF + m * 16) * FFc + j) = o;
                }
            }
        }
    }
};

template <class Epi, class Sched, bool ALIGN_EPI = false, bool SP2 = false>
__device__ __forceinline__ void gemm_phase(PG8_LAS unsigned char* lds, const Gemm g, const Sched& S, const Epi& E) {
    const int tid = opaque_tid(), wid = __builtin_amdgcn_readfirstlane(tid >> 6), lane = tid & 63, wr = wid >> 2, wc = wid & 3, fr = lane & 15, fq = lane >> 4;
    const int K = g.K, nt = K / BK;
    unsigned voffA[2], voffB[2];
#pragma unroll
    for (int i = 0; i < 2; ++i) { int R, C; stage_rc(tid * 16 + i * 8192, R, C); const int Rb = Epi::PERM ? ((R & ~31) + perm32(R & 31)) : R;
        voffA[i] = (unsigned)(R * K + C) * 2u; voffB[i] = (unsigned)(Rb * K + C) * 2u; }
    const size_t kstep = (size_t)(BK * 2);
    const size_t hstep = (size_t)HALF * K * 2;
    const size_t tstep = 2 * hstep;
    const unsigned ldsw = (unsigned)wid * 1024u;
    const int aoff = lds_byte(wr * 64 + fr, fq * 8), boff = lds_byte(wc * 32 + fr, fq * 8);
#define PG8_SA(b, h) (((b) * 2 + (h)) * HTB)
#define PG8_SB(b, h) ((4 + (b) * 2 + (h)) * HTB)
#define PG8_STAGE(bufoff, gbase, voff) do { _Pragma("unroll") for (int _i = 0; _i < 2; ++_i) \
        __builtin_amdgcn_global_load_lds((const unsigned*)((const char*)(gbase) + (voff)[_i]), (PG8_LAS unsigned*)(lds + (bufoff) + ldsw + _i * 8192), 16, 0, 0); } while (0)
#define PG8_LDA(dst, b, h) do { _Pragma("unroll") for (int m = 0; m < 4; ++m) _Pragma("unroll") for (int k = 0; k < 2; ++k) dst[m][k] = *(const PG8_LAS bf16x8*)(lds + PG8_SA(b, h) + aoff + m * 2048 + k * 1024); } while (0)
#define PG8_LDB(dst, b, h) do { _Pragma("unroll") for (int n = 0; n < 2; ++n) _Pragma("unroll") for (int k = 0; k < 2; ++k) dst[n][k] = *(const PG8_LAS bf16x8*)(lds + PG8_SB(b, h) + boff + n * 2048 + k * 1024); } while (0)
#define PG8_MMA(ai, bj, At, Bt) do { __builtin_amdgcn_s_setprio(1); _Pragma("unroll") for (int m = 0; m < 4; ++m) _Pragma("unroll") for (int n = 0; n < 2; ++n) _Pragma("unroll") for (int k = 0; k < 2; ++k) \
        acc[ai][bj][m][n] = __builtin_amdgcn_mfma_f32_16x16x32_bf16(Bt[n][k], At[m][k], acc[ai][bj][m][n], 0, 0, 0); __builtin_amdgcn_s_setprio(0); } while (0)
#define PG8_WAIT_V(n) asm volatile("s_waitcnt vmcnt(" #n ")" ::: "memory")
#define PG8_WAIT_L(n) asm volatile("s_waitcnt lgkmcnt(" #n ")" ::: "memory")
#define PG8_BAR __builtin_amdgcn_s_barrier()
#define PG8_SCHED __builtin_amdgcn_sched_barrier(0)
    Unit cur, nxt; int ui = 0;
    if (!S.next(0, cur)) return;
    f32x4 acc[2][2][4][2];
#pragma unroll
    for (int a = 0; a < 2; ++a)
#pragma unroll
        for (int b = 0; b < 2; ++b)
#pragma unroll
            for (int m = 0; m < 4; ++m)
#pragma unroll
                for (int n = 0; n < 2; ++n) acc[a][b][m][n] = (f32x4){0.f, 0.f, 0.f, 0.f};
    bf16x8 At[4][2], B0[2][2], B1[2][2];
    const char* cA = (const char*)g.A + (size_t)cur.pm * tstep; const char* cB = (const char*)g.Bt + (size_t)cur.pn * tstep;
    S.a_ready(cur);
    if constexpr (SP2) {
        PG8_STAGE(PG8_SB(0, 0), cB, voffB); PG8_STAGE(PG8_SB(0, 1), cB + hstep, voffB); PG8_STAGE(PG8_SA(0, 0), cA, voffA); PG8_STAGE(PG8_SA(0, 1), cA + hstep, voffA);
        if (wr == 1) PG8_BAR;
        PG8_WAIT_V(2); PG8_BAR;
        PG8_STAGE(PG8_SB(1, 0), cB + kstep, voffB); PG8_STAGE(PG8_SA(1, 0), cA + kstep, voffA); PG8_STAGE(PG8_SB(1, 1), cB + hstep + kstep, voffB);
        PG8_WAIT_V(6); PG8_BAR;
    } else {
        PG8_STAGE(PG8_SB(0, 0), cB, voffB); PG8_STAGE(PG8_SA(0, 0), cA, voffA); PG8_STAGE(PG8_SB(0, 1), cB + hstep, voffB); PG8_STAGE(PG8_SA(0, 1), cA + hstep, voffA);
        if (wr == 1) PG8_BAR;
        PG8_WAIT_V(4); PG8_BAR;
        PG8_STAGE(PG8_SB(1, 0), cB + kstep, voffB); PG8_STAGE(PG8_SA(1, 0), cA + kstep, voffA); PG8_STAGE(PG8_SB(1, 1), cB + hstep + kstep, voffB);
        PG8_WAIT_V(6); PG8_BAR;
    }
    for (;;) {
        const bool has_next = S.next(ui + 1, nxt);
        const char* nA = has_next ? (const char*)g.A + (size_t)nxt.pm * tstep : cA; const char* nB = has_next ? (const char*)g.Bt + (size_t)nxt.pn * tstep : cB;
        for (int t = 0; t < nt; t += 2) {
            const bool last = (t == nt - 2);
            const char* a1 = cA + (size_t)(t + 1) * kstep;
            const char* a2 = last ? nA : cA + (size_t)(t + 2) * kstep; const char* b2 = last ? nB : cB + (size_t)(t + 2) * kstep;
            const char* a3 = a2 + kstep; const char* b3 = b2 + kstep;
            if (last && has_next) S.a_ready(nxt);
            if constexpr (SP2) {
            PG8_LDB(B0, 0, 0); PG8_LDB(B1, 0, 1); PG8_SCHED; PG8_LDA(At, 0, 0); PG8_STAGE(PG8_SA(1, 1), a1 + hstep, voffA);
            PG8_WAIT_V(8); PG8_WAIT_L(0); PG8_BAR; PG8_MMA(0, 0, At, B0); PG8_MMA(0, 1, At, B1); PG8_BAR; PG8_SCHED;
            PG8_LDA(At, 0, 1); PG8_STAGE(PG8_SB(0, 0), b2, voffB); PG8_STAGE(PG8_SB(0, 1), b2 + hstep, voffB); PG8_STAGE(PG8_SA(0, 0), a2, voffA);
            PG8_WAIT_V(8); PG8_WAIT_L(0); PG8_BAR; PG8_MMA(1, 0, At, B0); PG8_MMA(1, 1, At, B1); PG8_BAR; PG8_SCHED;
            PG8_LDB(B0, 1, 0); PG8_LDB(B1, 1, 1); PG8_SCHED; PG8_LDA(At, 1, 0); PG8_STAGE(PG8_SA(0, 1), a2 + hstep, voffA);
            PG8_WAIT_V(8); PG8_WAIT_L(0); PG8_BAR; PG8_MMA(0, 0, At, B0); PG8_MMA(0, 1, At, B1); PG8_BAR; PG8_SCHED;
            PG8_LDA(At, 1, 1); PG8_STAGE(PG8_SB(1, 0), b3, voffB); PG8_STAGE(PG8_SB(1, 1), b3 + hstep, voffB); PG8_STAGE(PG8_SA(1, 0), a3, voffA);
            PG8_WAIT_V(8); PG8_WAIT_L(0); PG8_BAR; PG8_MMA(1, 0, At, B0); PG8_MMA(1, 1, At, B1); PG8_BAR; PG8_SCHED;
            } else {
            PG8_LDB(B0, 0, 0); PG8_SCHED; PG8_LDA(At, 0, 0); PG8_STAGE(PG8_SA(1, 1), a1 + hstep, voffA);
            PG8_WAIT_L(8); PG8_BAR; PG8_WAIT_L(0); PG8_MMA(0, 0, At, B0); PG8_BAR; PG8_SCHED;
            PG8_LDB(B1, 0, 1); PG8_STAGE(PG8_SB(0, 0), b2, voffB);
            PG8_BAR; PG8_WAIT_L(0); PG8_MMA(0, 1, At, B1); PG8_BAR;
            PG8_LDA(At, 0, 1); PG8_STAGE(PG8_SA(0, 0), a2, voffA);
            PG8_BAR; PG8_WAIT_L(0); PG8_MMA(1, 0, At, B0); PG8_BAR; PG8_SCHED;
            PG8_STAGE(PG8_SB(0, 1), b2 + hstep, voffB);
            PG8_WAIT_V(6); PG8_BAR; PG8_MMA(1, 1, At, B1); PG8_BAR;
            PG8_LDB(B0, 1, 0); PG8_SCHED; PG8_LDA(At, 1, 0); PG8_STAGE(PG8_SA(0, 1), a2 + hstep, voffA);
            PG8_WAIT_L(8); PG8_BAR; PG8_WAIT_L(0); PG8_MMA(0, 0, At, B0); PG8_BAR; PG8_SCHED;
            PG8_LDB(B1, 1, 1); PG8_STAGE(PG8_SB(1, 0), b3, voffB);
            PG8_BAR; PG8_WAIT_L(0); PG8_MMA(0, 1, At, B1); PG8_BAR;
            PG8_LDA(At, 1, 1); PG8_STAGE(PG8_SA(1, 0), a3, voffA);
            PG8_BAR; PG8_WAIT_L(0); PG8_MMA(1, 0, At, B0); PG8_BAR; PG8_SCHED;
            PG8_STAGE(PG8_SB(1, 1), b3 + hstep, voffB);
            PG8_WAIT_V(6); PG8_BAR; PG8_MMA(1, 1, At, B1); PG8_BAR;
            }
        }
        if constexpr (ALIGN_EPI) { if (wr == 0) PG8_BAR; }
#ifdef REP_E
        if constexpr (Epi::PERM) { E(acc, cur, wr, wc, fr, fq); asm volatile("" ::: "memory"); }
#endif
        if constexpr (!Epi::AFTER_DRAIN) { E(acc, cur, wr, wc, fr, fq); S.done(cur); }
        if (!has_next) break;
#pragma unroll
        for (int a = 0; a < 2; ++a)
#pragma unroll
            for (int b = 0; b < 2; ++b)
#pragma unroll
                for (int m = 0; m < 4; ++m)
#pragma unroll
                    for (int n = 0; n < 2; ++n) acc[a][b][m][n] = (f32x4){0.f, 0.f, 0.f, 0.f};
        cur = nxt; cA = nA; cB = nB; ++ui;
        if constexpr (ALIGN_EPI) { if (wr == 1) PG8_BAR; }
    }
    PG8_WAIT_V(0);
    if constexpr (!ALIGN_EPI) { if (wr == 0) PG8_BAR; }
    PG8_BAR;
    if constexpr (Epi::AFTER_DRAIN) { E.fused(acc, cur, wr, wc, fr, fq, lds, wid, lane); S.done(cur); }
#undef PG8_SA
#undef PG8_SB
#undef PG8_STAGE
#undef PG8_LDA
#undef PG8_LDB
#undef PG8_MMA
#undef PG8_WAIT_V
#undef PG8_WAIT_L
#undef PG8_BAR
#undef PG8_SCHED
}
}
#define DI __device__ __forceinline__
#define LAS __attribute__((address_space(3)))
typedef unsigned short bf16_t;
typedef short bf16x8 __attribute__((ext_vector_type(8)));
typedef short s16x4 __attribute__((ext_vector_type(4)));
typedef float f32x4 __attribute__((ext_vector_type(4)));
typedef float f32x16 __attribute__((ext_vector_type(16)));
typedef unsigned u32x4 __attribute__((ext_vector_type(4)));
typedef unsigned u32x2 __attribute__((ext_vector_type(2)));
#define MFMA32(a, b, c) __builtin_amdgcn_mfma_f32_32x32x16_bf16((a), (b), (c), 0, 0, 0)

constexpr int T_TOK = 16384, DM = 2048, SEQ = 4096, PIN = 7168, FF = 5632, FF2 = 11264, MODW = 12288;
constexpr float EPS = 1e-6f;
constexpr size_t MiB = 1u << 20;
constexpr size_t WS_MODP = 0, WS_MOD = 6 * MiB, WS_DEC = 7 * MiB, WS_STATS = 8 * MiB;
constexpr size_t WS_W = 16 * MiB;
constexpr size_t WS_WA = WS_W, WS_WO = WS_W + 28 * MiB, WS_WU = WS_WO + 8 * MiB, WS_WD = WS_WU + 44 * MiB;
constexpr size_t WS_HY = 118 * MiB;
constexpr size_t WS_BIG = 182 * MiB;
constexpr size_t WS_XB = WS_BIG;
constexpr size_t WS_Z = WS_BIG + 64 * MiB;
constexpr size_t WS_UT = WS_BIG + 224 * MiB;
constexpr size_t WS_U = 534 * MiB;
constexpr size_t WS_VT = WS_U, WS_ST = WS_U + 32 * MiB;
constexpr size_t WS_END = 710 * MiB;
constexpr int LDS_BYTES = 147456;

struct P {
    const float *x, *c, *ada_w, *ada_b, *mix_norm, *ffn_norm, *par_w_in, *par_w_out, *lb_logits, *hg_out_norm, *sg_w_in, *sg_v_gain, *sg_v_bias, *sg_w_pos, *sg_b_pos, *sg_w_out,
        *ffn_up, *conv_w, *conv_b, *ffn_down, *final_norm;
    float* out; unsigned char* ws;
};

DI unsigned pk2(float lo, float hi) { return pg8::cvt_pk_bf16(lo, hi); }
DI bf16_t f2bf(float x) { return (bf16_t)(pk2(x, 0.f) & 0xffffu); }
DI float bf2f(unsigned v) { return __uint_as_float(v << 16); }
DI float bflo(unsigned w) { return __uint_as_float(w << 16); }
DI float bfhi(unsigned w) { return __uint_as_float(w & 0xffff0000u); }
DI float wave_sum(float v) {
#define WS_DPP_ADD(ctrl) v += __builtin_bit_cast(float, __builtin_amdgcn_update_dpp(__builtin_bit_cast(int, v), __builtin_bit_cast(int, v), ctrl, 0xf, 0xf, false))
    WS_DPP_ADD(0xB1); WS_DPP_ADD(0x4E); WS_DPP_ADD(0x141); WS_DPP_ADD(0x140);
#undef WS_DPP_ADD
    v += __shfl_xor(v, 16); v += __shfl_xor(v, 32);
    return v;
}
DI int crow(int reg, int h) { return (reg & 3) + 8 * (reg >> 2) + 4 * h; }
DI f32x16 zero16() { f32x16 z;
#pragma unroll
    for (int i = 0; i < 16; ++i) z[i] = 0.f;
    return z; }
DI bf16x8 pack_step(const f32x16& x, int s) {
    u32x4 p; p.x = pk2(x[8 * s], x[8 * s + 1]); p.y = pk2(x[8 * s + 2], x[8 * s + 3]); p.z = pk2(x[8 * s + 4], x[8 * s + 5]); p.w = pk2(x[8 * s + 6], x[8 * s + 7]);
    return __builtin_bit_cast(bf16x8, p);
}

DI void transpose_item(const float* W, int K, int N, bf16_t* WT, LAS float* scr, int item, int lane, bool gv = false) {
    const int nblk = N / 32, kb = item / nblk, nb = item % nblk, k0 = 64 * kb, n0 = 32 * nb;
    const int nd0 = !gv ? n0 : (n0 < FF ? 256 * (n0 >> 7) + (n0 & 127) : 256 * ((n0 - FF) >> 7) + 128 + ((n0 - FF) & 127));
#pragma unroll 8
    for (int i = 0; i < 32; ++i) { const int kk = 2 * i + (lane >> 5); scr[kk * 33 + (lane & 31)] = W[(size_t)(k0 + kk) * N + n0 + (lane & 31)]; }
    asm volatile("s_waitcnt lgkmcnt(0)" ::: "memory");
    const int c = lane & 7;
#pragma unroll
    for (int j = 0; j < 4; ++j) { const int n = (lane >> 3) + 8 * j; const LAS float* s = scr + (8 * c) * 33 + n;
        u32x4 o; o.x = pk2(s[0 * 33], s[1 * 33]); o.y = pk2(s[2 * 33], s[3 * 33]); o.z = pk2(s[4 * 33], s[5 * 33]); o.w = pk2(s[6 * 33], s[7 * 33]);
        *(u32x4*)(WT + (size_t)(nd0 + n) * K + k0 + 8 * c) = o; }
    asm volatile("s_waitcnt lgkmcnt(0)" ::: "memory");
}
DI void convert_weights(const P& p, int layer, LAS unsigned char* L, int gw, int ngw, int wave, int lane) {
    LAS float* scr = (LAS float*)(L + wave * 16384);
    const float* w0 = layer ? p.sg_w_in : p.par_w_in; const int n0 = layer ? 4096 : PIN;
    const float* w1 = layer ? p.sg_w_out : p.par_w_out;
    const float* w2 = p.ffn_up + (size_t)layer * DM * FF2;
    const float* w3 = p.ffn_down + (size_t)layer * FF * DM;
    const int I0 = 32 * (n0 / 32), I1 = 32 * 64, I2 = 32 * (FF2 / 32), I3 = (FF / 64) * 64;
    for (int it = gw; it < I0 + I1 + I2 + I3; it += ngw) {
        int r = it;
        if (r < I0) { transpose_item(w0, DM, n0, (bf16_t*)(p.ws + WS_WA), scr, r, lane); continue; } r -= I0;
        if (r < I1) { transpose_item(w1, DM, DM, (bf16_t*)(p.ws + WS_WO), scr, r, lane); continue; } r -= I1;
        if (r < I2) { transpose_item(w2, DM, FF2, (bf16_t*)(p.ws + WS_WU), scr, r, lane, true); continue; } r -= I2;
        transpose_item(w3, FF, DM, (bf16_t*)(p.ws + WS_WD), scr, r, lane);
    }
}
DI void ada_partials(const P& p, LAS unsigned char* L) {
    LAS float* condl = (LAS float*)(L + 8 * 16384);
    float* modp = (float*)(p.ws + WS_MODP);
    const int tid = opaque_tid();
    for (int item = blockIdx.x; item < 768; item += gridDim.x) {
        const int l = item / 384, r = item % 384, cb = r / 16, ks = r % 16;
        __syncthreads();
        { const int b = tid >> 7, k = tid & 127; const float cv = p.c[b * DM + ks * 128 + k]; condl[tid] = cv * __builtin_amdgcn_rcpf(1.f + __expf(-cv)); }
        __syncthreads();
        const int col = cb * 512 + tid;
        const float* w = p.ada_w + ((size_t)l * DM + ks * 128) * MODW + col;
        float a0 = 0.f, a1 = 0.f, a2 = 0.f, a3 = 0.f;
#pragma unroll 8
        for (int k = 0; k < 128; ++k) { const float wv = w[(size_t)k * MODW]; a0 += condl[k] * wv; a1 += condl[128 + k] * wv; a2 += condl[256 + k] * wv; a3 += condl[384 + k] * wv; }
        float* o = modp + ((size_t)(ks * 2 + l) * 4) * MODW + col;
        o[0] = a0; o[MODW] = a1; o[2 * MODW] = a2; o[3 * MODW] = a3;
    }
}
DI void mod_reduce(const P& p) {
    const float* modp = (const float*)(p.ws + WS_MODP); float* mod = (float*)(p.ws + WS_MOD);
    for (int idx = blockIdx.x * 512 + opaque_tid(); idx < 2 * 4 * MODW; idx += gridDim.x * 512) {
        const int l = idx / (4 * MODW), col = idx % MODW; float s = p.ada_b[l * MODW + col];
#pragma unroll
        for (int ks = 0; ks < 16; ++ks) s += modp[(size_t)ks * (2 * 4 * MODW) + idx];
        mod[idx] = s;
    }
}
DI void norm_rows(const float* X, const float* gain, const float* sh, const float* sc, bf16_t* H, int gw, int ngw, int lane) {
    for (int m = gw; m < T_TOK; m += ngw) {
        const int b = m >> 12;
        const f32x4* xr = (const f32x4*)(X + (size_t)m * DM) + lane;
        f32x4 v[8]; float s = 0.f;
#pragma unroll
        for (int j = 0; j < 8; ++j) { v[j] = xr[64 * j]; s += (v[j].x * v[j].x + v[j].y * v[j].y) + (v[j].z * v[j].z + v[j].w * v[j].w); }
        const float rstd = rsqrtf(wave_sum(s) * (1.f / DM) + EPS);
        const f32x4* gp = (const f32x4*)gain + lane; const f32x4* scp = (const f32x4*)(sc + (size_t)b * MODW) + lane; const f32x4* shp = (const f32x4*)(sh + (size_t)b * MODW) + lane;
        u32x2* o = (u32x2*)(H + (size_t)m * DM) + lane;
#pragma unroll
        for (int j = 0; j < 8; ++j) { const f32x4 r = v[j] * rstd * gp[64 * j] * (scp[64 * j] + 1.0f) + shp[64 * j]; u32x2 w; w.x = pk2(r.x, r.y); w.y = pk2(r.z, r.w); o[64 * j] = w; }
    }
}
DI void final_norm_rows(float* X, const float* gain, int gw, int ngw, int lane) {
    for (int m = gw; m < T_TOK; m += ngw) {
        f32x4* xr = (f32x4*)(X + (size_t)m * DM) + lane;
        f32x4 v[8]; float s = 0.f;
#pragma unroll
        for (int j = 0; j < 8; ++j) { v[j] = xr[64 * j]; s += (v[j].x * v[j].x + v[j].y * v[j].y) + (v[j].z * v[j].z + v[j].w * v[j].w); }
        const float rstd = rsqrtf(wave_sum(s) * (1.f / DM) + EPS);
        const f32x4* gp = (const f32x4*)gain + lane;
#pragma unroll
        for (int j = 0; j < 8; ++j) xr[64 * j] = v[j] * rstd * gp[64 * j];
    }
}
DI void unpack8(const u32x4 w, float (&f)[8]) { f[0] = bflo(w.x); f[1] = bfhi(w.x); f[2] = bflo(w.y); f[3] = bfhi(w.y); f[4] = bflo(w.z); f[5] = bfhi(w.z); f[6] = bflo(w.w); f[7] = bfhi(w.w); }
DI void ld8f(const float* p, float (&f)[8]) { const f32x4 a = *(const f32x4*)p, b = *(const f32x4*)(p + 4); f[0] = a.x; f[1] = a.y; f[2] = a.z; f[3] = a.w; f[4] = b.x; f[5] = b.y; f[6] = b.z; f[7] = b.w; }
DI void conv_act(const bf16_t* A, const float* cw, const float* cb, bf16_t* U) {
    const int total = (T_TOK / 8) * (FF / 8);
    for (int it = blockIdx.x * 512 + opaque_tid(); it < total; it += gridDim.x * 512) {
        const int j8 = it % (FF / 8), tb = it / (FF / 8), j = j8 * 8, t0 = tb * 8;
        float wg0[8], wg1[8], wg2[8], wv0[8], wv1[8], wv2[8], bg[8], bv[8];
        ld8f(cw + j, wg0); ld8f(cw + FF2 + j, wg1); ld8f(cw + 2 * FF2 + j, wg2);
        ld8f(cw + FF + j, wv0); ld8f(cw + FF2 + FF + j, wv1); ld8f(cw + 2 * FF2 + FF + j, wv2);
        ld8f(cb + j, bg); ld8f(cb + FF + j, bv);
        float g2[8], g1[8], v2[8], v1[8];
        if ((t0 & (SEQ - 1)) == 0) {
#pragma unroll
            for (int e = 0; e < 8; ++e) { g2[e] = 0.f; g1[e] = 0.f; v2[e] = 0.f; v1[e] = 0.f; }
        } else {
            unpack8(*(const u32x4*)(A + (size_t)(t0 - 2) * FF2 + j), g2); unpack8(*(const u32x4*)(A + (size_t)(t0 - 1) * FF2 + j), g1);
            unpack8(*(const u32x4*)(A + (size_t)(t0 - 2) * FF2 + FF + j), v2); unpack8(*(const u32x4*)(A + (size_t)(t0 - 1) * FF2 + FF + j), v1);
        }
#pragma unroll
        for (int i = 0; i < 8; ++i) {
            float g0[8], v0[8];
            unpack8(*(const u32x4*)(A + (size_t)(t0 + i) * FF2 + j), g0); unpack8(*(const u32x4*)(A + (size_t)(t0 + i) * FF2 + FF + j), v0);
            float o[8];
#pragma unroll
            for (int e = 0; e < 8; ++e) {
                const float ag = bg[e] + wg0[e] * g2[e] + wg1[e] * g1[e] + wg2[e] * g0[e];
                const float av = bv[e] + wv0[e] * v2[e] + wv1[e] * v1[e] + wv2[e] * v0[e];
                o[e] = ag * __builtin_amdgcn_rcpf(1.f + __expf(-ag)) * av;
                g2[e] = g1[e]; g1[e] = g0[e]; v2[e] = v1[e]; v1[e] = v0[e];
            }
            u32x4 w; w.x = pk2(o[0], o[1]); w.y = pk2(o[2], o[3]); w.z = pk2(o[4], o[5]); w.w = pk2(o[6], o[7]);
            *(u32x4*)(U + (size_t)(t0 + i) * FF + j) = w;
        }
    }
}
DI void conv_fixup(const float* SB, const float* cw, const float* cb, bf16_t* U) {
    for (int it = blockIdx.x * 512 + opaque_tid(); it < 64 * (FF / 4); it += gridDim.x * 512) {
        const int pm = it / (FF / 4), j = (it % (FF / 4)) * 4;
        const int tc = 256 * (j >> 7) + (j & 127);
        const f32x4 zero4 = {0.f, 0.f, 0.f, 0.f};
        const bool head = (pm & 15) == 0;
        const float* s0 = SB + (size_t)(pm * 4) * FF2 + tc; const float* sp = SB + (size_t)((pm - 1) * 4) * FF2 + tc;
        const f32x4 g0 = *(const f32x4*)(s0), g1 = *(const f32x4*)(s0 + FF2), v0 = *(const f32x4*)(s0 + 128), v1 = *(const f32x4*)(s0 + FF2 + 128);
        const f32x4 gA = head ? zero4 : *(const f32x4*)(sp + 2 * FF2), gB = head ? zero4 : *(const f32x4*)(sp + 3 * FF2);
        const f32x4 vA = head ? zero4 : *(const f32x4*)(sp + 2 * FF2 + 128), vB = head ? zero4 : *(const f32x4*)(sp + 3 * FF2 + 128);
        const f32x4 wg0 = *(const f32x4*)(cw + j), wg1 = *(const f32x4*)(cw + FF2 + j), wg2 = *(const f32x4*)(cw + 2 * FF2 + j), bg = *(const f32x4*)(cb + j);
        const f32x4 wv0 = *(const f32x4*)(cw + FF + j), wv1 = *(const f32x4*)(cw + FF2 + FF + j), wv2 = *(const f32x4*)(cw + 2 * FF2 + FF + j), bv = *(const f32x4*)(cb + FF + j);
        const f32x4 ag0 = bg + wg0 * gA + wg1 * gB + wg2 * g0, av0 = bv + wv0 * vA + wv1 * vB + wv2 * v0;
        const f32x4 ag1 = bg + wg0 * gB + wg1 * g0 + wg2 * g1, av1 = bv + wv0 * vB + wv1 * v0 + wv2 * v1;
        float r0[4], r1[4];
#pragma unroll
        for (int e = 0; e < 4; ++e) { r0[e] = ag0[e] * __builtin_amdgcn_rcpf(1.f + __expf(-ag0[e])) * av0[e]; r1[e] = ag1[e] * __builtin_amdgcn_rcpf(1.f + __expf(-ag1[e])) * av1[e]; }
        u32x2 o; o.x = pk2(r0[0], r0[1]); o.y = pk2(r0[2], r0[3]); *(u32x2*)(U + (size_t)(pm * 256) * FF + j) = o;
        o.x = pk2(r1[0], r1[1]); o.y = pk2(r1[2], r1[3]); *(u32x2*)(U + (size_t)(pm * 256 + 1) * FF + j) = o;
    }
}
DI void v_transpose(const bf16_t* PROJ, bf16_t* VT, LAS unsigned char* L) {
    const int tid = opaque_tid();
    for (int item = blockIdx.x; item < 1024; item += gridDim.x) {
        const int bh = item >> 5, sb = item & 31, b = bh >> 3, hh = bh & 7;
        __syncthreads();
#pragma unroll
        for (int j = 0; j < 4; ++j) { const int c = tid + 512 * j, s = c >> 4, d8 = c & 15;
            const u32x4 v = *(const u32x4*)(PROJ + ((size_t)b * SEQ + sb * 128 + s) * PIN + 2048 + hh * 128 + d8 * 8);
            *(LAS u32x4*)(L + s * 272 + d8 * 16) = v; }
        __syncthreads();
#pragma unroll
        for (int j = 0; j < 4; ++j) { const int c = tid + 512 * j, d = c >> 4, s8 = c & 15;
            unsigned e[8];
#pragma unroll
            for (int i = 0; i < 8; ++i) e[i] = *(const LAS bf16_t*)(L + (s8 * 8 + i) * 272 + d * 2);
            u32x4 o; o.x = e[0] | (e[1] << 16); o.y = e[2] | (e[3] << 16); o.z = e[4] | (e[5] << 16); o.w = e[6] | (e[7] << 16);
            *(u32x4*)(VT + ((size_t)bh * 128 + d) * SEQ + sb * 128 + s8 * 8) = o; }
    }
}
DI void hg_gates(const LAS unsigned char* rawf, const float* lbl, int part, int hh, int d, float (&G)[16], float (&kk)[16]) {
    const float l0 = lbl[hh * 128 + d], l1 = lbl[1024 + hh * 128 + d]; const float lb = __builtin_amdgcn_rcpf(1.f + __expf(l1 - l0));
    float run = 0.f;
#pragma unroll
    for (int i = 0; i < 16; ++i) {
        const float fl = bf2f(*(const LAS bf16_t*)(rawf + (16 * part + i) * 272 + d * 2));
        const float sig = __builtin_amdgcn_rcpf(1.f + __expf(-fl)); const float f = lb + (1.f - lb) * sig;
        kk[i] = (1.f - lb) * (1.f - sig); run += __builtin_amdgcn_logf(f) * 0.69314718056f; G[i] = run;
    }
}
DI void hg_raw_load(const bf16_t* PROJ, int ch, int colbase, unsigned roff, u32x4 (&rg)[2]) {
    const int bh = ch >> 6, n = ch & 63, b = bh >> 3, hh = bh & 7;
    const bf16_t* src = PROJ + ((size_t)b * SEQ + n * 64) * PIN + colbase + hh * 128;
    rg[0] = *(const u32x4*)(src + roff); rg[1] = *(const u32x4*)(src + (size_t)32 * PIN + roff);
}
DI void hg_raw_store(LAS unsigned char* img, int tid, const u32x4 (&rg)[2]) {
    LAS unsigned char* wp = img + (tid >> 4) * 272 + (tid & 15) * 16;
    *(LAS u32x4*)wp = rg[0]; *(LAS u32x4*)(wp + 32 * 272) = rg[1];
}
DI void hg_col16(const LAS unsigned char* img, int part, int d, u32x4& a, u32x4& c) {
    unsigned e[16];
#pragma unroll
    for (int i = 0; i < 16; ++i) e[i] = *(const LAS bf16_t*)(img + (16 * part + i) * 272 + d * 2);
    a.x = e[0] | (e[1] << 16); a.y = e[2] | (e[3] << 16); a.z = e[4] | (e[5] << 16); a.w = e[6] | (e[7] << 16);
    c.x = e[8] | (e[9] << 16); c.y = e[10] | (e[11] << 16); c.z = e[12] | (e[13] << 16); c.w = e[14] | (e[15] << 16);
}
DI void hg_phase_a(const P& p, const bf16_t* PROJ, float* UT, float* DEC, LAS unsigned char* L) {
    const int tid = opaque_tid(), w = __builtin_amdgcn_readfirstlane(tid >> 6), lane = tid & 63, r = lane & 31, lh = lane >> 5;
    LAS unsigned char* kendT = L; LAS unsigned char* vT = L + 18432; LAS float* psum = (LAS float*)(L + 36864);
    LAS unsigned char* rawf = L + 40960; LAS unsigned char* rawv = L + 40960 + 17408;
    const int d = tid & 127, part = tid >> 7;
    const unsigned roff = (unsigned)((tid >> 4) * PIN + (tid & 15) * 8);
    u32x4 rf[2], rv[2];
    if ((int)blockIdx.x < 2048) { hg_raw_load(PROJ, blockIdx.x, 4096, roff, rf); hg_raw_load(PROJ, blockIdx.x, 5120, roff, rv); }
    for (int ch = blockIdx.x; ch < 2048; ch += gridDim.x) {
        const int bh = ch >> 6, hh = bh & 7;
        __syncthreads();
        hg_raw_store(rawf, tid, rf); hg_raw_store(rawv, tid, rv);
        if (ch + (int)gridDim.x < 2048) { hg_raw_load(PROJ, ch + gridDim.x, 4096, roff, rf); hg_raw_load(PROJ, ch + gridDim.x, 5120, roff, rv); }
        __syncthreads();
        float G[16], kk[16];
        hg_gates(rawf, p.lb_logits, part, hh, d, G, kk);
        psum[part * 128 + d] = G[15];
        { u32x4 a, c; hg_col16(rawv, part, d, a, c); *(LAS u32x4*)(vT + d * 144 + part * 32) = a; *(LAS u32x4*)(vT + d * 144 + part * 32 + 16) = c; }
        __syncthreads();
        float off = 0.f, tot = 0.f;
#pragma unroll
        for (int q = 0; q < 4; ++q) { const float v = psum[q * 128 + d]; tot += v; off += (q < part) ? v : 0.f; }
        { float ke[16];
#pragma unroll
          for (int i = 0; i < 16; ++i) ke[i] = kk[i] * __expf(tot - (off + G[i]));
          u32x4 a, c; a.x = pk2(ke[0], ke[1]); a.y = pk2(ke[2], ke[3]); a.z = pk2(ke[4], ke[5]); a.w = pk2(ke[6], ke[7]);
          c.x = pk2(ke[8], ke[9]); c.y = pk2(ke[10], ke[11]); c.z = pk2(ke[12], ke[13]); c.w = pk2(ke[14], ke[15]);
          *(LAS u32x4*)(kendT + d * 144 + part * 32) = a; *(LAS u32x4*)(kendT + d * 144 + part * 32 + 16) = c; }
        if (part == 0) DEC[(size_t)ch * 128 + d] = __expf(tot);
        __syncthreads();
        const int dvt = w >> 1, dkt0 = (w & 1) * 2;
        f32x16 acc0 = zero16(), acc1 = zero16();
#pragma unroll
        for (int ks = 0; ks < 4; ++ks) {
            const bf16x8 a = *(const LAS bf16x8*)(vT + (32 * dvt + r) * 144 + (16 * ks + 8 * lh) * 2);
            const bf16x8 b0 = *(const LAS bf16x8*)(kendT + (32 * dkt0 + r) * 144 + (16 * ks + 8 * lh) * 2);
            const bf16x8 b1 = *(const LAS bf16x8*)(kendT + (32 * (dkt0 + 1) + r) * 144 + (16 * ks + 8 * lh) * 2);
            acc0 = MFMA32(a, b0, acc0); acc1 = MFMA32(a, b1, acc1);
        }
        float* o = UT + (size_t)ch * 16384;
#pragma unroll
        for (int reg = 0; reg < 16; ++reg) { const int dv = 32 * dvt + crow(reg, lh); o[dv * 128 + 32 * dkt0 + r] = acc0[reg]; o[dv * 128 + 32 * (dkt0 + 1) + r] = acc1[reg]; }
    }
}
DI void hg_phase_b(const float* UT, const float* DEC, bf16_t* ST) {
    for (int idx = blockIdx.x * 512 + opaque_tid(); idx < 32 * 4096; idx += gridDim.x * 512) {
        const int bh = idx >> 12, rem = idx & 4095, dv = rem >> 5, dk4 = (rem & 31) * 4;
        f32x4 st = {0.f, 0.f, 0.f, 0.f};
#pragma unroll 4
        for (int n = 0; n < 64; ++n) {
            const size_t ch = (size_t)bh * 64 + n;
            u32x2 w; w.x = pk2(st.x, st.y); w.y = pk2(st.z, st.w);
            *(u32x2*)(ST + ch * 16384 + dv * 128 + dk4) = w;
            const f32x4 u = *(const f32x4*)(UT + ch * 16384 + dv * 128 + dk4), dc = *(const f32x4*)(DEC + ch * 128 + dk4);
            st = dc * st + u;
        }
    }
}
DI void hg_phase_c(const P& p, const bf16_t* PROJ, const bf16_t* ST, bf16_t* Y, LAS unsigned char* L, unsigned* qcnt) {
    const int tid = opaque_tid(), w = __builtin_amdgcn_readfirstlane(tid >> 6), lane = tid & 63, r = lane & 31, lh = lane >> 5;
    LAS unsigned char* qd = L; LAS unsigned char* ki = L + 17408; LAS unsigned char* vT = L + 34816; LAS float* psum = (LAS float*)(L + 52224); LAS float* rp = (LAS float*)(L + 54272);
    LAS unsigned char* rawf = L + 57344; LAS unsigned char* rawv = rawf + 17408; LAS unsigned char* rawq = rawv + 17408;
    const int d = tid & 127, part = tid >> 7;
    const unsigned roff = (unsigned)((tid >> 4) * PIN + (tid & 15) * 8);
    u32x4 rf[2], rv[2], rq[2];
    LAS unsigned* qs = (LAS unsigned*)(L + 139424);
    __syncthreads();
    if (tid == 0) qs[0] = __hip_atomic_fetch_add(qcnt, 1u, __ATOMIC_RELAXED, __HIP_MEMORY_SCOPE_AGENT);
    __syncthreads();
    int ch = (int)qs[0], par = 0;
    if (ch < 2048) { hg_raw_load(PROJ, ch, 4096, roff, rf); hg_raw_load(PROJ, ch, 5120, roff, rv); hg_raw_load(PROJ, ch, 3072, roff, rq); }
    while (ch < 2048) {
        const int bh = ch >> 6, n = ch & 63, b = bh >> 3, hh = bh & 7;
        if (tid == 0) qs[par ^ 1] = __hip_atomic_fetch_add(qcnt, 1u, __ATOMIC_RELAXED, __HIP_MEMORY_SCOPE_AGENT);
        __syncthreads();
        const int nxt = (int)qs[par ^ 1];
        hg_raw_store(rawf, tid, rf); hg_raw_store(rawv, tid, rv); hg_raw_store(rawq, tid, rq);
        if (nxt < 2048) { hg_raw_load(PROJ, nxt, 4096, roff, rf); hg_raw_load(PROJ, nxt, 5120, roff, rv); hg_raw_load(PROJ, nxt, 3072, roff, rq); }
        __syncthreads();
        const int dt = w & 3, tt = w >> 2;
        bf16x8 stf[8];
        { const bf16_t* STc = ST + (size_t)ch * 16384 + (32 * dt + r) * 128 + 8 * lh;
#pragma unroll
          for (int ks = 0; ks < 8; ++ks) stf[ks] = *(const bf16x8*)(STc + 16 * ks); }
        const size_t trow = (size_t)b * SEQ + n * 64 + 32 * tt + r;
        u32x2 ggv[4]; f32x4 ogv[4];
#pragma unroll
        for (int g4 = 0; g4 < 4; ++g4) { const int dv0 = 32 * dt + 8 * g4 + 4 * lh; ggv[g4] = *(const u32x2*)(PROJ + trow * PIN + 6144 + hh * 128 + dv0); ogv[g4] = *(const f32x4*)(p.hg_out_norm + hh * 128 + dv0); }
        float G[16], kk[16];
        hg_gates(rawf, p.lb_logits, part, hh, d, G, kk);
        psum[part * 128 + d] = G[15];
        { u32x4 a, c; hg_col16(rawv, part, d, a, c);
          u32x2 t2; t2.x = a.x; t2.y = a.y; *(LAS u32x2*)(vT + d * 136 + part * 32) = t2; t2.x = a.z; t2.y = a.w; *(LAS u32x2*)(vT + d * 136 + part * 32 + 8) = t2;
          t2.x = c.x; t2.y = c.y; *(LAS u32x2*)(vT + d * 136 + part * 32 + 16) = t2; t2.x = c.z; t2.y = c.w; *(LAS u32x2*)(vT + d * 136 + part * 32 + 24) = t2; }
        float qs[16];
#pragma unroll
        for (int i = 0; i < 16; ++i) { const float ql = bf2f(*(const LAS bf16_t*)(rawq + (16 * part + i) * 272 + d * 2)); qs[i] = ql * __builtin_amdgcn_rcpf(1.f + __expf(-ql)); }
        __syncthreads();
        float off = 0.f;
#pragma unroll
        for (int q = 0; q < 4; ++q) { const float v = psum[q * 128 + d]; off += (q < part) ? v : 0.f; }
#pragma unroll
        for (int i = 0; i < 16; ++i) { const float g = off + G[i];
            *(LAS bf16_t*)(qd + (16 * part + i) * 272 + d * 2) = f2bf(qs[i] * __expf(g));
            *(LAS bf16_t*)(ki + (16 * part + i) * 272 + d * 2) = f2bf(kk[i] * __expf(-g)); }
        __syncthreads();
        bf16x8 qfr[8];
#pragma unroll
        for (int ks = 0; ks < 8; ++ks) qfr[ks] = *(const LAS bf16x8*)(qd + (32 * tt + r) * 272 + (16 * ks + 8 * lh) * 2);
        f32x16 O = zero16();
#pragma unroll
        for (int st = 0; st < 2; ++st) {
            if (st <= tt) {
                f32x16 X = zero16();
#pragma unroll
                for (int ks = 0; ks < 8; ++ks) { const bf16x8 a = *(const LAS bf16x8*)(ki + (32 * st + r) * 272 + (16 * ks + 8 * lh) * 2); X = MFMA32(a, qfr[ks], X); }
                if (st == tt) {
#pragma unroll
                    for (int reg = 0; reg < 16; ++reg) X[reg] = (crow(reg, lh) > r) ? 0.f : X[reg];
                }
#pragma unroll
                for (int sp = 0; sp < 2; ++sp) {
                    const bf16x8 pf = pack_step(X, sp);
                    const s16x4 lo = *(const LAS s16x4*)(vT + (32 * dt + r) * 136 + (32 * st + 16 * sp + 4 * lh) * 2);
                    const s16x4 hi = *(const LAS s16x4*)(vT + (32 * dt + r) * 136 + (32 * st + 16 * sp + 4 * lh) * 2 + 16);
                    O = MFMA32(__builtin_shufflevector(lo, hi, 0, 1, 2, 3, 4, 5, 6, 7), pf, O);
                }
            }
        }
#pragma unroll
        for (int ks = 0; ks < 8; ++ks) O = MFMA32(stf[ks], qfr[ks], O);
        float ss = 0.f;
#pragma unroll
        for (int reg = 0; reg < 16; ++reg) ss += O[reg] * O[reg];
        ss += __shfl_xor(ss, 32);
        if (lh == 0) rp[dt * 64 + 32 * tt + r] = ss;
        __syncthreads();
        const float tot = (rp[32 * tt + r] + rp[64 + 32 * tt + r]) + (rp[128 + 32 * tt + r] + rp[192 + 32 * tt + r]);
        const float rstd = rsqrtf(tot * (1.f / 128.f) + EPS);
#pragma unroll
        for (int g4 = 0; g4 < 4; ++g4) {
            const int dv0 = 32 * dt + 8 * g4 + 4 * lh;
            const u32x2 gg = ggv[g4];
            const f32x4 og = ogv[g4];
            const float g0 = bflo(gg.x), g1 = bfhi(gg.x), g2 = bflo(gg.y), g3 = bfhi(gg.y);
            const float o0 = O[4 * g4] * rstd * og.x * (g0 * __builtin_amdgcn_rcpf(1.f + __expf(-g0))), o1 = O[4 * g4 + 1] * rstd * og.y * (g1 * __builtin_amdgcn_rcpf(1.f + __expf(-g1)));
            const float o2 = O[4 * g4 + 2] * rstd * og.z * (g2 * __builtin_amdgcn_rcpf(1.f + __expf(-g2))), o3 = O[4 * g4 + 3] * rstd * og.w * (g3 * __builtin_amdgcn_rcpf(1.f + __expf(-g3)));
            u32x2 wv; wv.x = pk2(o0, o1); wv.y = pk2(o2, o3);
            *(u32x2*)(Y + trow * DM + 1024 + hh * 128 + dv0) = wv;
        }
        ch = nxt; par ^= 1;
    }
}
template <bool DIAG> DI void sb_elem(f32x16& X, float& run, int tr, bool lh0) {
    const float scale2 = 0.08838834764831845f * 1.4426950408889634f;
    f32x16 KP; float gp[4], pg[4];
#pragma unroll
    for (int g = 0; g < 4; ++g) {
        float a0 = 1.f;
#pragma unroll
        for (int i = 0; i < 4; ++i) { const int reg = 4 * g + i;
            const float z2 = X[reg] * scale2; const float e = __builtin_amdgcn_exp2f(-__builtin_fabsf(z2)); const float inv = __builtin_amdgcn_rcpf(1.f + e);
            float keep = (z2 >= 0.f) ? e * inv : inv;
            if (DIAG) keep = (8 * g + i < tr) ? keep : 1.f;
            KP[reg] = keep; a0 *= keep; }
        gp[g] = a0;
    }
#pragma unroll
    for (int g = 0; g < 4; ++g) pg[g] = __shfl_xor(gp[g], 32);
#pragma unroll
    for (int g = 3; g >= 0; --g) {
        float c = lh0 ? run * pg[g] : run;
#pragma unroll
        for (int i = 3; i >= 0; --i) { const int reg = 4 * g + i; const float cn = c * KP[reg]; X[reg] = c - cn; c = cn; }
        run *= gp[g] * pg[g];
    }
}
DI void attn_phase(const bf16_t* PROJ, const bf16_t* VT, bf16_t* Y, LAS unsigned char* L, unsigned* qcnt) {
    const int tid = opaque_tid(), w = __builtin_amdgcn_readfirstlane(tid >> 6), lane = tid & 63, r = lane & 31, lh = lane >> 5;
    constexpr int ATT_BUF = 34816;
    LAS unsigned char* Kt = L; LAS unsigned char* Vt = L + 17408; LAS unsigned char* Qs = L + 2 * ATT_BUF;
    const unsigned koff = (unsigned)((tid >> 4) * PIN + (tid & 15) * 8), voff = (unsigned)((tid >> 3) * SEQ + (tid & 7) * 8);
    const unsigned yoff = (unsigned)((32 * w + r) * DM + 4 * lh);
    const float lhm = lh == 0 ? 1.f : 0.f;
    LAS unsigned* qslot = (LAS unsigned*)(L + 139392);
    for (;;) {
        {
            __syncthreads();
            if (tid == 0) *qslot = __hip_atomic_fetch_add(qcnt, 1u, __ATOMIC_RELAXED, __HIP_MEMORY_SCOPE_AGENT);
            __syncthreads();
            const int unit = (int)*qslot;
            if (unit >= 512) break;
            const int qb = 15 - (unit >> 5), bh = unit & 31, b = bh >> 3, hh = bh & 7, q0 = qb * 256;
            const size_t rowb = (size_t)b * SEQ;
            const int t = q0 + 32 * w + r;
            { const bf16_t* qp = PROJ + (rowb + q0) * PIN + hh * 128; LAS unsigned char* qwr = Qs + (tid >> 4) * 272 + (tid & 15) * 16;
#pragma unroll
              for (int j = 0; j < 8; ++j) *(LAS u32x4*)(qwr + j * 32 * 272) = *(const u32x4*)(qp + (size_t)j * 32 * PIN + koff); }
            const LAS unsigned char* qrd = Qs + (32 * w + r) * 272 + lh * 16;
            f32x16 O0 = zero16(), O1 = zero16(), O2 = zero16(), O3 = zero16();
            float R = 1.f;
            const int nkt = 4 * qb + 4;
            u32x4 kreg[2], vreg[2];
            const bf16_t* kb0 = PROJ + rowb * PIN + 1024 + hh * 128; const bf16_t* vb0 = VT + (size_t)bh * 128 * SEQ;
            LAS unsigned char* kwr = Kt + (tid >> 4) * 272 + (tid & 15) * 16; LAS unsigned char* vwr = Vt + (tid >> 3) * 136 + (tid & 7) * 16;
#define ATT_LOAD(ktile) { const bf16_t* kb = kb0 + (size_t)(64 * (ktile)) * PIN; const bf16_t* vb = vb0 + 64 * (ktile); \
              kreg[0] = *(const u32x4*)(kb + koff); kreg[1] = *(const u32x4*)(kb + 32 * PIN + koff); \
              vreg[0] = *(const u32x4*)(vb + voff); vreg[1] = *(const u32x4*)(vb + 64 * SEQ + voff); }
#define ATT_WRITE(bo) { *(LAS u32x4*)(kwr + (bo)) = kreg[0]; *(LAS u32x4*)(kwr + (bo) + 32 * 272) = kreg[1]; \
              u32x2 lo, hi; lo.x = vreg[0].x; lo.y = vreg[0].y; hi.x = vreg[0].z; hi.y = vreg[0].w; *(LAS u32x2*)(vwr + (bo)) = lo; *(LAS u32x2*)(vwr + (bo) + 8) = hi; \
              lo.x = vreg[1].x; lo.y = vreg[1].y; hi.x = vreg[1].z; hi.y = vreg[1].w; *(LAS u32x2*)(vwr + (bo) + 64 * 136) = lo; *(LAS u32x2*)(vwr + (bo) + 64 * 136 + 8) = hi; }
            ATT_LOAD(nkt - 1)
            ATT_WRITE(0)
            ATT_LOAD(nkt - 2)
            __syncthreads();
            int bo = 0; bool walive = true;
            for (int kt = nkt - 1; kt >= 0; --kt, bo ^= ATT_BUF) {
                if (64 * kt <= q0 + 32 * w + 30 && walive) {
                    float run = R;
#pragma unroll
                    for (int st = 1; st >= 0; --st) {
                        f32x16 X = zero16();
#pragma unroll
                        for (int ks = 0; ks < 8; ++ks) {
                            const bf16x8 a = *(const LAS bf16x8*)(Kt + bo + (32 * st + r) * 272 + (16 * ks + 8 * lh) * 2);
                            const bf16x8 qv = *(const LAS bf16x8*)(qrd + 32 * ks);
                            X = MFMA32(a, qv, X);
                        }
                        sb_elem<true>(X, run, t - (64 * kt + 32 * st + 4 * lh), lh == 0);
#pragma unroll
                        for (int sp = 0; sp < 2; ++sp) {
                            const bf16x8 pf = pack_step(X, sp);
                            const int so = (32 * st + 16 * sp + 4 * lh) * 2;
#define ATT_PV(Od, dt) { const s16x4 lo = *(const LAS s16x4*)(Vt + bo + (32 * dt + r) * 136 + so); const s16x4 hi = *(const LAS s16x4*)(Vt + bo + (32 * dt + r) * 136 + so + 16); \
                         Od = MFMA32(__builtin_shufflevector(lo, hi, 0, 1, 2, 3, 4, 5, 6, 7), pf, Od); }
                            ATT_PV(O0, 0) ATT_PV(O1, 1) ATT_PV(O2, 2) ATT_PV(O3, 3)
#undef ATT_PV
                        }
                    }
                    R = run;
                }
                if (kt > 0) { ATT_WRITE(bo ^ ATT_BUF) if (kt > 1) ATT_LOAD(kt - 2) }
                LAS unsigned* vote = (LAS unsigned*)(L + 139296) + (bo ? 8 : 0);
                { const bool any = __ballot(R != 0.f) != 0ull; walive = any; if (lane == 0) vote[w] = any ? 1u : 0u; }
                __syncthreads();
                { const u32x4 v0 = *(const LAS u32x4*)(vote), v1 = *(const LAS u32x4*)(vote + 4);
                  if (((v0.x | v0.y) | (v0.z | v0.w) | (v1.x | v1.y) | (v1.z | v1.w)) == 0u) break; }
            }
#undef ATT_LOAD
#undef ATT_WRITE
            bf16_t* yrow = Y + (rowb + q0) * DM + hh * 128 + yoff;
#pragma unroll
            for (int g = 0; g < 4; ++g) {
                u32x2 v;
                v.x = pk2(O0[4 * g], O0[4 * g + 1]); v.y = pk2(O0[4 * g + 2], O0[4 * g + 3]); *(u32x2*)(yrow + 8 * g) = v;
                v.x = pk2(O1[4 * g], O1[4 * g + 1]); v.y = pk2(O1[4 * g + 2], O1[4 * g + 3]); *(u32x2*)(yrow + 32 + 8 * g) = v;
                v.x = pk2(O2[4 * g], O2[4 * g + 1]); v.y = pk2(O2[4 * g + 2], O2[4 * g + 3]); *(u32x2*)(yrow + 64 + 8 * g) = v;
                v.x = pk2(O3[4 * g], O3[4 * g + 1]); v.y = pk2(O3[4 * g + 2], O3[4 * g + 3]); *(u32x2*)(yrow + 96 + 8 * g) = v;
            }
        }
    }
}
DI void sg_stats(const bf16_t* Z, float* stats, int gw, int ngw, int lane) {
    for (int m = gw; m < T_TOK; m += ngw) {
        const u32x4* zr = (const u32x4*)(Z + (size_t)m * 4096 + 2048) + lane;
        float f[4][8]; float s = 0.f;
#pragma unroll
        for (int j = 0; j < 4; ++j) { unpack8(zr[64 * j], f[j]);
#pragma unroll
            for (int e = 0; e < 8; ++e) s += f[j][e]; }
        const float mean = wave_sum(s) * (1.f / 2048.f); float q = 0.f;
#pragma unroll
        for (int j = 0; j < 4; ++j)
#pragma unroll
            for (int e = 0; e < 8; ++e) { const float dd = f[j][e] - mean; q += dd * dd; }
        const float rstd = rsqrtf(wave_sum(q) * (1.f / 2048.f) + EPS);
        if (lane == 0) { stats[2 * m] = mean; stats[2 * m + 1] = rstd; }
    }
}
DI void sg_mix(const P& p, const bf16_t* Z, const float* stats, bf16_t* Y, LAS unsigned char* L) {
    const int tid = opaque_tid(), w = __builtin_amdgcn_readfirstlane(tid >> 6), lane = tid & 63, r = lane & 31, lh = lane >> 5;
    LAS unsigned char* Wp = L; LAS unsigned char* vT = L + 34816; LAS float* At = (LAS float*)(L + 34816 + 69632); LAS float* Bt = At + 128; LAS unsigned char* rawv = L + 105472;
    const int c = tid & 255, sg = tid >> 8;
    for (int u = blockIdx.x; u < 1024; u += gridDim.x) {
        const int g = u & 7, cn = u >> 3; const size_t base = (size_t)cn * 128;
        u32x4 vq[8];
        { const bf16_t* zp = Z + (base + (tid >> 5)) * 4096 + 2048 + g * 256 + (tid & 31) * 8;
#pragma unroll
          for (int j = 0; j < 8; ++j) vq[j] = *(const u32x4*)(zp + (size_t)(16 * j) * 4096); }
        f32x4 wv[8], st0[8], st1[8];
#pragma unroll
        for (int j = 0; j < 8; ++j) { const int idx = tid + 512 * j, t = idx >> 5, s4 = (idx & 31) * 4;
            wv[j] = *(const f32x4*)(p.sg_w_pos + ((size_t)g * 128 + t) * 128 + s4);
            st0[j] = *(const f32x4*)(stats + 2 * (base + s4)); st1[j] = *(const f32x4*)(stats + 2 * (base + s4) + 4); }
        __syncthreads();
#pragma unroll
        for (int j = 0; j < 8; ++j) { const int idx = tid + 512 * j, t = idx >> 5, s4 = (idx & 31) * 4;
            const float w0 = s4 <= t ? wv[j].x : 0.f, w1 = s4 + 1 <= t ? wv[j].y : 0.f, w2 = s4 + 2 <= t ? wv[j].z : 0.f, w3 = s4 + 3 <= t ? wv[j].w : 0.f;
            u32x2 o; o.x = pk2(w0 * st0[j].y, w1 * st0[j].w); o.y = pk2(w2 * st1[j].y, w3 * st1[j].w);
            *(LAS u32x2*)(Wp + t * 272 + s4 * 2) = o;
            float a = bflo(o.x) * st0[j].x + bfhi(o.x) * st0[j].z + bflo(o.y) * st1[j].x + bfhi(o.y) * st1[j].z;
            float bsum = (w0 + w1) + (w2 + w3);
#define SG_DPP_ADD(x, ctrl) x += __builtin_bit_cast(float, __builtin_amdgcn_update_dpp(__builtin_bit_cast(int, x), __builtin_bit_cast(int, x), ctrl, 0xf, 0xf, false))
            SG_DPP_ADD(a, 0xB1); SG_DPP_ADD(bsum, 0xB1); SG_DPP_ADD(a, 0x4E); SG_DPP_ADD(bsum, 0x4E);
            SG_DPP_ADD(a, 0x141); SG_DPP_ADD(bsum, 0x141); SG_DPP_ADD(a, 0x140); SG_DPP_ADD(bsum, 0x140);
#undef SG_DPP_ADD
            a += __shfl_xor(a, 16); bsum += __shfl_xor(bsum, 16);
            if ((lane & 31) == 0) { At[t] = a; Bt[t] = bsum; } }
#pragma unroll
        for (int hv = 0; hv < 2; ++hv) {
            if (hv) __syncthreads();
#pragma unroll
            for (int j = 0; j < 4; ++j) *(LAS u32x4*)(rawv + ((tid >> 5) + 16 * j) * 528 + (tid & 31) * 16) = vq[4 * hv + j];
            __syncthreads();
#pragma unroll
            for (int k = 0; k < 4; ++k) { unsigned e[8];
#pragma unroll
                for (int i = 0; i < 8; ++i) e[i] = *(const LAS bf16_t*)(rawv + (sg * 32 + 8 * k + i) * 528 + c * 2);
                u32x4 o; o.x = e[0] | (e[1] << 16); o.y = e[2] | (e[3] << 16); o.z = e[4] | (e[5] << 16); o.w = e[6] | (e[7] << 16);
                *(LAS u32x4*)(vT + c * 272 + (64 * hv + sg * 32 + 8 * k) * 2) = o; }
        }
        __syncthreads();
        bf16x8 af[8];
#pragma unroll
        for (int ks = 0; ks < 8; ++ks) af[ks] = *(const LAS bf16x8*)(vT + (32 * w + r) * 272 + (16 * ks + 8 * lh) * 2);
        const f32x4 gam[4] = { *(const f32x4*)(p.sg_v_gain + g * 256 + 32 * w + 4 * lh), *(const f32x4*)(p.sg_v_gain + g * 256 + 32 * w + 8 + 4 * lh),
                               *(const f32x4*)(p.sg_v_gain + g * 256 + 32 * w + 16 + 4 * lh), *(const f32x4*)(p.sg_v_gain + g * 256 + 32 * w + 24 + 4 * lh) };
        const f32x4 bet[4] = { *(const f32x4*)(p.sg_v_bias + g * 256 + 32 * w + 4 * lh), *(const f32x4*)(p.sg_v_bias + g * 256 + 32 * w + 8 + 4 * lh),
                               *(const f32x4*)(p.sg_v_bias + g * 256 + 32 * w + 16 + 4 * lh), *(const f32x4*)(p.sg_v_bias + g * 256 + 32 * w + 24 + 4 * lh) };
#pragma unroll
        for (int tt = 0; tt < 4; ++tt) {
            const int t = 32 * tt + r; const size_t row = base + t;
            u32x2 uu[4];
#pragma unroll
            for (int g4 = 0; g4 < 4; ++g4) uu[g4] = *(const u32x2*)(Z + row * 4096 + g * 256 + 32 * w + 8 * g4 + 4 * lh);
            const float bp = p.sg_b_pos[g * 128 + t], at = At[t], bt = Bt[t];
            f32x16 acc = zero16();
#pragma unroll
            for (int ks = 0; ks < 8; ++ks) if (ks <= 2 * tt + 1) { const bf16x8 bw = *(const LAS bf16x8*)(Wp + (32 * tt + r) * 272 + (16 * ks + 8 * lh) * 2); acc = MFMA32(af[ks], bw, acc); }
#pragma unroll
            for (int g4 = 0; g4 < 4; ++g4) {
                const float m0 = gam[g4].x * (acc[4 * g4] - at) + bet[g4].x * bt + bp, m1 = gam[g4].y * (acc[4 * g4 + 1] - at) + bet[g4].y * bt + bp;
                const float m2 = gam[g4].z * (acc[4 * g4 + 2] - at) + bet[g4].z * bt + bp, m3 = gam[g4].w * (acc[4 * g4 + 3] - at) + bet[g4].w * bt + bp;
                u32x2 o; o.x = pk2(bflo(uu[g4].x) * m0, bfhi(uu[g4].x) * m1); o.y = pk2(bflo(uu[g4].y) * m2, bfhi(uu[g4].y) * m3);
                *(u32x2*)(Y + row * DM + g * 256 + 32 * w + 8 * g4 + 4 * lh) = o; }
        }
    }
}
constexpr size_t WS_BAR = 9 * MiB;
constexpr size_t WS_QCNT = WS_BAR + 32768;
constexpr size_t WS_ROWSS = WS_BAR + 65536, WS_PCNT = WS_BAR + 524288, WS_ZERO_BYTES = 1048576;
constexpr int LDS_BARST = 139264;
#define XB_TMO      128
#define XB_XCNT(j)  (256  + 64 * (j))
#define XB_XSUB(j)  (1280 + 64 * (j))
#define XB_XGEN(j)  (2304 + 64 * (j))
#define XB_TOP      3328
#define XB_TOPGEN   3392
#define XCD_BAR_WORDS 3456
#define XB_SPIN_CAP (1u << 18)

__device__ __forceinline__ unsigned xb_ld(unsigned* p)              { return __hip_atomic_load(p, __ATOMIC_RELAXED, __HIP_MEMORY_SCOPE_AGENT); }
__device__ __forceinline__ unsigned xb_add(unsigned* p, unsigned v) { return __hip_atomic_fetch_add(p, v, __ATOMIC_RELAXED, __HIP_MEMORY_SCOPE_AGENT); }
__device__ __forceinline__ unsigned xb_xcc_id() { return (unsigned)__builtin_amdgcn_s_getreg((3 << 11) | 20) & 0xFu; }
#define XB_SPIN(cond, bar) do { unsigned _sp = 0; while (cond) { __builtin_amdgcn_s_sleep(1); \
    if ((++_sp & 255u) == 0u) { if (xb_ld(&(bar)[XB_TMO])) break; if (_sp > XB_SPIN_CAP) { atomicAdd(&(bar)[XB_TMO], 1u); break; } } } } while (0)

struct XcdBarrier {
    unsigned* bar; unsigned x;
    volatile LAS unsigned* st;
};

__device__ __forceinline__ XcdBarrier xcd_barrier_post(unsigned* bar, volatile LAS unsigned* st) {
    XcdBarrier b; b.bar = bar; b.x = xb_xcc_id(); b.st = st;
    if (threadIdx.x == 0) (void)xb_add(&bar[XB_XCNT(b.x)], 1u);
    return b;
}
__device__ __forceinline__ void xcd_barrier_complete(unsigned* bar, unsigned x, unsigned& nloc, unsigned& nx) {
    const unsigned G = gridDim.x * gridDim.y * gridDim.z;
    unsigned sum, cnt, mine, sp = 0u;
    for (;;) {
        sum = 0u; cnt = 0u; mine = 0u;
#pragma unroll
        for (unsigned j = 0; j < 16; ++j) { const unsigned c = xb_ld(&bar[XB_XCNT(j)]); sum += c; cnt += (c > 0u) ? 1u : 0u; mine = (j == x) ? c : mine; }
        if (sum == G) break;
        __builtin_amdgcn_s_sleep(1);
        if ((++sp & 255u) == 0u) { if (xb_ld(&bar[XB_TMO])) break; if (sp > XB_SPIN_CAP) { atomicAdd(&bar[XB_TMO], 1u); break; } }
    }
    nloc = mine > 0u ? mine : 1u; nx = cnt > 0u ? cnt : 1u;
}

__device__ __forceinline__ void xcd_barrier(const XcdBarrier& b) {
    asm volatile("s_waitcnt vmcnt(0)" ::: "memory");
    __syncthreads();
    if (threadIdx.x == 0) {
        unsigned* bar = b.bar;
        __builtin_amdgcn_s_waitcnt(0);
        unsigned nloc = b.st[0], nx = b.st[1];
        if (nloc == 0u) { xcd_barrier_complete(bar, b.x, nloc, nx); b.st[0] = nloc; b.st[1] = nx; }
        const unsigned old = xb_add(&bar[XB_XSUB(b.x)], 1u);
        const unsigned gen = old / nloc;
        if (old + 1u == (gen + 1u) * nloc) {
            __builtin_amdgcn_fence(__ATOMIC_RELEASE, "agent");
            asm volatile("s_waitcnt vmcnt(0)" ::: "memory");
            const unsigned og = xb_add(&bar[XB_TOP], 1u);
            const unsigned tg = og / nx;
            if (og + 1u == (tg + 1u) * nx) xb_add(&bar[XB_TOPGEN], 1u);
            else XB_SPIN(xb_ld(&bar[XB_TOPGEN]) == tg, bar);
            __builtin_amdgcn_fence(__ATOMIC_ACQUIRE, "agent");
            xb_add(&bar[XB_XGEN(b.x)], 1u);
            asm volatile("s_waitcnt vmcnt(0)" ::: "memory");
        } else {
            XB_SPIN(xb_ld(&bar[XB_XGEN(b.x)]) == gen, bar);
            __builtin_amdgcn_fence(__ATOMIC_ACQUIRE, "agent");
            asm volatile("s_waitcnt vmcnt(0)" ::: "memory");
        }
    }
    __syncthreads();
}


template <class Epi, class Sched = pg8::StaticOrder> DI void run_gemm(LAS unsigned char* lds, const bf16_t* A, const bf16_t* Bt, int N, int K, const Epi& E) {
    pg8::Gemm g{A, Bt, T_TOK, N, K}; Sched S; S.init(T_TOK, N, (int)gridDim.x, (int)blockIdx.x);
    pg8::gemm_phase<Epi, Sched, true, true>((PG8_LAS unsigned char*)lds, g, S, E);
}

#define PHASE_HEAD() const int tid = opaque_tid(), lane = tid & 63, wave = __builtin_amdgcn_readfirstlane(tid >> 6); const int gw = blockIdx.x * 8 + wave, ngw = gridDim.x * 8; (void)lane; (void)gw; (void)ngw;
#define WSP(T, off) ((T*)(p.ws + (off)))
typedef const __attribute__((address_space(4))) unsigned long long* KAP;
DI P load_args() {
    KAP kp = (KAP)__builtin_amdgcn_kernarg_segment_ptr();
    asm volatile("" : "+s"(kp));
    P p;
#define KARGF(i) ((const float*)(const __attribute__((address_space(1))) float*)kp[i])
    p.x = KARGF(0); p.c = KARGF(1); p.ada_w = KARGF(2); p.ada_b = KARGF(3); p.mix_norm = KARGF(4); p.ffn_norm = KARGF(5);
    p.par_w_in = KARGF(6); p.par_w_out = KARGF(7); p.lb_logits = KARGF(8); p.hg_out_norm = KARGF(9); p.sg_w_in = KARGF(10);
    p.sg_v_gain = KARGF(11); p.sg_v_bias = KARGF(12); p.sg_w_pos = KARGF(13); p.sg_b_pos = KARGF(14); p.sg_w_out = KARGF(15);
    p.ffn_up = KARGF(16); p.conv_w = KARGF(17); p.conv_b = KARGF(18); p.ffn_down = KARGF(19); p.final_norm = KARGF(20);
    p.out = (float*)(__attribute__((address_space(1))) float*)kp[21]; p.ws = (unsigned char*)(__attribute__((address_space(1))) unsigned char*)kp[22];
#undef KARGF
    return p;
}
#define LDSP ((LAS unsigned char*)lds_raw)
#ifndef REP_A
#define REP_A 1
#endif
#ifndef REP_B
#define REP_B 1
#endif
#ifndef REP_C
#define REP_C 1
#endif
#ifndef REP_S
#define REP_S 1
#endif
#define GSYNC() do { for (int rs_ = 0; rs_ < REP_S; ++rs_) { const P pb_ = load_args(); XcdBarrier xb_; xb_.bar = (unsigned*)(pb_.ws + WS_BAR); xb_.x = xb_xcc_id(); xb_.st = (volatile LAS unsigned*)(LDSP + LDS_BARST); xcd_barrier(xb_); } } while (0)
#define RA for (int ra_ = 0; ra_ < REP_A; ++ra_)
#define RB for (int rb_ = 0; rb_ < REP_B; ++rb_)
#define RC for (int rc_ = 0; rc_ < REP_C; ++rc_)

#define FUSED_NORM (gridDim.x == 256)
#define RNORM(id) WSP(float, WS_ROWSS) + (id) * 16384, WSP(unsigned, WS_PCNT) + (id) * 4096
template <int LAYER> DI void ffn_block(unsigned char* lds_raw, cg::grid_group& grid) {
    if (!FUSED_NORM) {
        RA { const P p = load_args(); PHASE_HEAD(); const float* modl = WSP(const float, WS_MOD) + (size_t)LAYER * 4 * MODW;
          norm_rows(p.out, p.ffn_norm + LAYER * DM, modl + 3 * DM, modl + 4 * DM, WSP(bf16_t, WS_HY), gw, ngw, lane); }
        GSYNC();
    }
    RC { const P p = load_args(); pg8::EpiConv E{WSP(bf16_t, WS_U), WSP(float, WS_UT), p.conv_w + (size_t)LAYER * 3 * FF2, p.conv_b + (size_t)LAYER * FF2, (PG8_LAS unsigned char*)(LDSP + 131072)};
         run_gemm(LDSP, WSP(const bf16_t, WS_HY), WSP(const bf16_t, WS_WU), FF2, DM, E); }
    GSYNC();
    { const P p = load_args(); conv_fixup(WSP(const float, WS_UT), p.conv_w + (size_t)LAYER * 3 * FF2, p.conv_b + (size_t)LAYER * FF2, WSP(bf16_t, WS_U)); }
    GSYNC();
    { const P p = load_args(); const float* modl = WSP(const float, WS_MOD) + (size_t)LAYER * 4 * MODW;
      if (FUSED_NORM) {
          const float* mod1 = WSP(const float, WS_MOD) + 4 * MODW;
          if (LAYER == 0) { pg8::EpiResidNorm<1, 1> E{WSP(bf16_t, WS_XB), WSP(bf16_t, WS_XB), modl + 5 * DM, p.mix_norm + DM, mod1 + DM, mod1, WSP(bf16_t, WS_HY), RNORM(1)}; run_gemm<pg8::EpiResidNorm<1, 1>, pg8::PanelOrder>(LDSP, WSP(const bf16_t, WS_U), WSP(const bf16_t, WS_WD), DM, FF, E); }
          else { pg8::EpiResidNorm<1, 2> E{WSP(bf16_t, WS_XB), p.out, modl + 5 * DM, p.final_norm, nullptr, nullptr, WSP(bf16_t, WS_HY), RNORM(3)}; run_gemm<pg8::EpiResidNorm<1, 2>, pg8::PanelOrder>(LDSP, WSP(const bf16_t, WS_U), WSP(const bf16_t, WS_WD), DM, FF, E); }
      } else { pg8::EpiResid E{p.out, p.out, modl + 5 * DM}; run_gemm(LDSP, WSP(const bf16_t, WS_U), WSP(const bf16_t, WS_WD), DM, FF, E); } }
    GSYNC();
}

__global__ void __launch_bounds__(512, 2) fwd_megakernel(P p_arg) {
    extern __shared__ __attribute__((aligned(16))) unsigned char lds_raw[];
    cg::grid_group grid = cg::this_grid();
    { if (threadIdx.x < 2) ((volatile LAS unsigned*)(LDSP + LDS_BARST))[threadIdx.x] = 0u;
      __syncthreads();
      const P pb_ = load_args(); if (pb_.ws == nullptr) grid.sync();
      (void)xcd_barrier_post((unsigned*)(pb_.ws + WS_BAR), (volatile LAS unsigned*)(LDSP + LDS_BARST)); }
    RA { const P p = load_args(); PHASE_HEAD(); convert_weights(p, 0, LDSP, gw, ngw, wave, lane); ada_partials(p, LDSP); }
    GSYNC();
    RA { const P p = load_args(); mod_reduce(p); }
    GSYNC();
    RA { const P p = load_args(); PHASE_HEAD(); const float* mod0 = WSP(const float, WS_MOD); norm_rows(p.x, p.mix_norm, mod0, mod0 + DM, WSP(bf16_t, WS_HY), gw, ngw, lane); }
    GSYNC();
    RC { const P p = load_args(); pg8::EpiBf16 E{WSP(bf16_t, WS_BIG), PIN, 0}; run_gemm(LDSP, WSP(const bf16_t, WS_HY), WSP(const bf16_t, WS_WA), PIN, DM, E); }
    GSYNC();
    RB { const P p = load_args(); v_transpose(WSP(const bf16_t, WS_BIG), WSP(bf16_t, WS_VT), LDSP); }
#ifdef REP_HGA
    for (int rq_ = 0; rq_ < 2; ++rq_)
#endif
    RB { const P p = load_args(); hg_phase_a(p, WSP(const bf16_t, WS_BIG), WSP(float, WS_UT), WSP(float, WS_DEC), LDSP); }
    GSYNC();
    RB { const P p = load_args(); hg_phase_b(WSP(const float, WS_UT), WSP(const float, WS_DEC), WSP(bf16_t, WS_ST)); }
    GSYNC();
#ifdef REP_ATT
    for (int rq_ = 0; rq_ < REP_ATT; ++rq_)
#endif
    RB { const P p = load_args(); attn_phase(WSP(const bf16_t, WS_BIG), WSP(const bf16_t, WS_VT), WSP(bf16_t, WS_HY), LDSP, WSP(unsigned, WS_QCNT)); }
#ifdef REP_HGC
    for (int rq_ = 0; rq_ < 2; ++rq_)
#endif
    RB { const P p = load_args(); hg_phase_c(p, WSP(const bf16_t, WS_BIG), WSP(const bf16_t, WS_ST), WSP(bf16_t, WS_HY), LDSP, WSP(unsigned, WS_QCNT) + 128); }
    GSYNC();
    { const P p = load_args(); const float* mod0 = WSP(const float, WS_MOD);
      if (FUSED_NORM) { pg8::EpiResidNorm<0, 1> E{p.x, WSP(bf16_t, WS_XB), mod0 + 2 * DM, p.ffn_norm, mod0 + 4 * DM, mod0 + 3 * DM, WSP(bf16_t, WS_HY), RNORM(0)}; run_gemm<pg8::EpiResidNorm<0, 1>, pg8::PanelOrder>(LDSP, WSP(const bf16_t, WS_HY), WSP(const bf16_t, WS_WO), DM, DM, E); }
      else { pg8::EpiResid E{p.x, p.out, mod0 + 2 * DM}; run_gemm(LDSP, WSP(const bf16_t, WS_HY), WSP(const bf16_t, WS_WO), DM, DM, E); } }
    GSYNC();
    ffn_block<0>(lds_raw, grid);
    RA { const P p = load_args(); PHASE_HEAD(); const float* mod1 = WSP(const float, WS_MOD) + 4 * MODW;
      if (!FUSED_NORM) norm_rows(p.out, p.mix_norm + DM, mod1, mod1 + DM, WSP(bf16_t, WS_HY), gw, ngw, lane);
      convert_weights(p, 1, LDSP, gw, ngw, wave, lane); }
    GSYNC();
    RC { const P p = load_args(); pg8::EpiBf16 E{WSP(bf16_t, WS_Z), 4096, 1}; run_gemm(LDSP, WSP(const bf16_t, WS_HY), WSP(const bf16_t, WS_WA), 4096, DM, E); }
    GSYNC();
    RB { const P p = load_args(); PHASE_HEAD(); sg_stats(WSP(const bf16_t, WS_Z), WSP(float, WS_STATS), gw, ngw, lane); }
    GSYNC();
#ifdef REP_SG
    for (int rq_ = 0; rq_ < 2; ++rq_)
#endif
    RB { const P p = load_args(); sg_mix(p, WSP(const bf16_t, WS_Z), WSP(const float, WS_STATS), WSP(bf16_t, WS_HY), LDSP); }
    GSYNC();
    { const P p = load_args(); const float* mod1 = WSP(const float, WS_MOD) + 4 * MODW;
      if (FUSED_NORM) { pg8::EpiResidNorm<1, 1> E{WSP(bf16_t, WS_XB), WSP(bf16_t, WS_XB), mod1 + 2 * DM, p.ffn_norm + DM, mod1 + 4 * DM, mod1 + 3 * DM, WSP(bf16_t, WS_HY), RNORM(2)}; run_gemm<pg8::EpiResidNorm<1, 1>, pg8::PanelOrder>(LDSP, WSP(const bf16_t, WS_HY), WSP(const bf16_t, WS_WO), DM, DM, E); }
      else { pg8::EpiResid E{p.out, p.out, mod1 + 2 * DM}; run_gemm(LDSP, WSP(const bf16_t, WS_HY), WSP(const bf16_t, WS_WO), DM, DM, E); } }
    GSYNC();
    ffn_block<1>(lds_raw, grid);
    if (!FUSED_NORM) { const P p = load_args(); PHASE_HEAD(); final_norm_rows(p.out, p.final_norm, gw, ngw, lane); }
}

extern "C" void kernel_launch(void* const* d_in, const int* in_sizes, int n_in, void* d_out, int out_size, void* d_ws, size_t ws_size, hipStream_t stream) {
    static int grid = 0;
    if (grid == 0) {
        if (n_in != 21 || out_size != T_TOK * DM || ws_size < WS_END) { fprintf(stderr, "kernel_launch: unexpected shapes: n_in %d out %d ws %zu (need %zu)\n", n_in, out_size, ws_size, (size_t)WS_END); grid = -1; return; }
        int dev = 0, cus = 0, per_cu = 0;
        hipGetDevice(&dev); hipDeviceGetAttribute(&cus, hipDeviceAttributeMultiprocessorCount, dev);
        if (hipFuncSetAttribute((const void*)fwd_megakernel, hipFuncAttributeMaxDynamicSharedMemorySize, LDS_BYTES) != hipSuccess) { fprintf(stderr, "kernel_launch: hipFuncSetAttribute failed\n"); grid = -1; return; }
        if (hipOccupancyMaxActiveBlocksPerMultiprocessor(&per_cu, (const void*)fwd_megakernel, 512, LDS_BYTES) != hipSuccess || per_cu < 1) { fprintf(stderr, "kernel_launch: occupancy query says %d\n", per_cu); per_cu = 1; }
        (void)hipGetLastError();
        grid = cus * 1;
    }
    if (grid < 0) return;
    if (hipMemsetAsync((char*)d_ws + WS_BAR, 0, WS_ZERO_BYTES, stream) != hipSuccess) { fprintf(stderr, "kernel_launch: memset failed\n"); return; }
    P p{};
    const float** f = (const float**)&p;
    for (int i = 0; i < 21; ++i) f[i] = (const float*)d_in[i];
    p.out = (float*)d_out; p.ws = (unsigned char*)d_ws;
    void* args[] = {&p};
    hipError_t e = hipLaunchCooperativeKernel((const void*)fwd_megakernel, dim3(grid), dim3(512), args, LDS_BYTES, stream);
    if (e != hipSuccess) fprintf(stderr, "cooperative launch failed: %s (grid %d)\n", hipGetErrorString(e), grid);
}
```
